# Optimizing an MI355X kernel written in HIP

```python
import math
import jax, jax.numpy as jnp
from jax import lax

D_MODEL = 1024
BATCH = 16
SEQ = 256
DEPTH = 4
DEC_BATCH = 2
DEC_SEQ = 4096
PAST_LEN = 512

GRID_W = 64
HEAD_DIM = 64
A_HEADS = 8
A_DK = HEAD_DIM
A_DV = HEAD_DIM
A_W = A_HEADS * A_DV
CONV_K = 5
CHUNK = 64
B_HEADS = 8
B_KV = 2
C_HEADS = 8
C_KV = 2
WINDOW = 128
QBLOCK = 128
D_FF = 4 * D_MODEL
ROPE_THETA = 10000.0
EPS = 1e-6
IN_SIZES = (3 * A_W, A_W, 2 * A_HEADS, 2 * A_HEADS,
            B_HEADS * HEAD_DIM, B_KV * HEAD_DIM, B_KV * HEAD_DIM,
            C_HEADS * HEAD_DIM, C_KV * HEAD_DIM, C_KV * HEAD_DIM, 3 * D_MODEL)
IN_COLS = sum(IN_SIZES)

kernel_name = "hybrid_flow_prefix_gdn_gqa_swa"


def _rmsnorm(x, w):
    xf = x.astype(jnp.float32)
    y = xf * lax.rsqrt(jnp.mean(xf * xf, axis=-1, keepdims=True) + EPS)
    return (y * w.astype(jnp.float32)).astype(x.dtype)


def _l2norm(x):
    xf = x.astype(jnp.float32)
    return xf * lax.rsqrt(jnp.sum(xf * xf, axis=-1, keepdims=True) + EPS)


def _mod_norm(x, w, shift, scale):
    return _rmsnorm(x, w) * (1 + scale) + shift


def _split_cols(proj):
    parts, off = [], 0
    for size in IN_SIZES:
        parts.append(proj[..., off:off + size])
        off += size
    return parts


def _heads(x, n_heads):
    return x.reshape(x.shape[0], x.shape[1], n_heads, HEAD_DIM)


def _axial_rope_tables(n_tokens):
    rows = n_tokens // GRID_W
    row_id = jnp.repeat(jnp.arange(rows, dtype=jnp.float32), GRID_W)
    col_id = jnp.tile(jnp.arange(GRID_W, dtype=jnp.float32), rows)
    n_freq = HEAD_DIM // 4
    inv_freq = ROPE_THETA ** (-jnp.arange(n_freq, dtype=jnp.float32) / n_freq)
    ang = jnp.concatenate([row_id[:, None] * inv_freq, col_id[:, None] * inv_freq], axis=-1)
    return jnp.cos(ang), jnp.sin(ang)


def _rope(x, cos, sin):
    half = HEAD_DIM // 2
    xf = x.astype(jnp.float32)
    x1, x2 = xf[..., :half], xf[..., half:]
    cs, sn = cos[None, :, None, :], sin[None, :, None, :]
    return jnp.concatenate([x1 * cs - x2 * sn, x2 * cs + x1 * sn], axis=-1).astype(x.dtype)


def _short_conv(x, w):
    ch = x.shape[-1]
    return lax.conv_general_dilated(x, w[:, None, :].astype(x.dtype), (1,),
                                    [(CONV_K // 2, CONV_K // 2)],
                                    dimension_numbers=('NWC', 'WIO', 'NWC'),
                                    feature_group_count=ch)


def _gdn_features(qkv_raw, beta_raw, alpha_raw, conv_w, a_log, dt_bias):
    qkv = jax.nn.silu(_short_conv(qkv_raw, conv_w))
    bn, t = qkv.shape[0], qkv.shape[1]
    q, k, v = jnp.split(qkv, 3, axis=-1)
    q = _l2norm(q.reshape(bn, t, A_HEADS, A_DK)) * (A_DK ** -0.5)
    k = _l2norm(k.reshape(bn, t, A_HEADS, A_DK))
    v = v.reshape(bn, t, A_HEADS, A_DV)
    beta = jax.nn.sigmoid(beta_raw.astype(jnp.float32)).reshape(bn, t, 2, A_HEADS)
    g = -jnp.exp(a_log.astype(jnp.float32)) * jax.nn.softplus(
        alpha_raw.astype(jnp.float32).reshape(bn, t, 2, A_HEADS) + dt_bias.astype(jnp.float32))
    return q, k, v, beta, g


def _chunked_delta(q, k, v, beta, g, s0):
    bn, t, h, dk = q.shape
    dv = v.shape[-1]
    n = t // CHUNK

    def chunks4(x):
        return x.astype(jnp.float32).reshape(bn, n, CHUNK, h, x.shape[-1]).transpose(1, 0, 3, 2, 4)

    def chunks3(x):
        return x.astype(jnp.float32).reshape(bn, n, CHUNK, h).transpose(1, 0, 3, 2)

    q_, k_, v_ = chunks4(q), chunks4(k), chunks4(v)
    b_, g_ = chunks3(beta), chunks3(g)
    gc = jnp.cumsum(g_, axis=-1)
    idx = jnp.arange(CHUNK)
    incl = idx[:, None] >= idx[None, :]
    strict = idx[:, None] > idx[None, :]
    diff = gc[..., :, None] - gc[..., None, :]
    decay = jnp.where(incl, jnp.exp(jnp.where(incl, diff, 0.0)), 0.0)
    kk = jnp.einsum('nbhid,nbhjd->nbhij', k_, k_)
    a_mat = jnp.where(strict, b_[..., :, None] * kk * decay, 0.0) + jnp.eye(CHUNK, dtype=jnp.float32)
    eg = jnp.exp(gc)
    rhs = jnp.concatenate([b_[..., None] * v_, (b_ * eg)[..., None] * k_], axis=-1)
    sol = lax.linalg.triangular_solve(a_mat, rhs, left_side=True, lower=True, unit_diagonal=True)
    u_p, w = sol[..., :dv], sol[..., dv:]
    attn = jnp.einsum('nbhid,nbhjd->nbhij', q_, k_) * decay
    q_g = q_ * eg[..., None]
    k_g = k_ * jnp.exp(gc[..., -1:] - gc)[..., None]
    g_last = jnp.exp(gc[..., -1])

    def step(s, xs):
        up_c, w_c, q_c, a_c, k_c, gl = xs
        u = up_c - jnp.einsum('bhcd,bhde->bhce', w_c, s)
        o = jnp.einsum('bhcd,bhde->bhce', q_c, s) + jnp.einsum('bhij,bhje->bhie', a_c, u)
        s_new = gl[..., None, None] * s + jnp.einsum('bhcd,bhce->bhde', k_c, u)
        return s_new, o

    s_fin, o = lax.scan(step, s0.astype(jnp.float32), (u_p, w, q_g, attn, k_g, g_last))
    o = o.transpose(1, 0, 3, 2, 4).reshape(bn, t, h, dv)
    return o, s_fin


def _gdn_bidir(q, k, v, beta, g, s_fwd, s_bwd):
    o_f, sf = _chunked_delta(q, k, v, beta[:, :, 0], g[:, :, 0], s_fwd)
    flip = lambda a: jnp.flip(a, axis=1)
    o_b, sb = _chunked_delta(flip(q), flip(k), flip(v), flip(beta[:, :, 1]), flip(g[:, :, 1]), s_bwd)
    return o_f + flip(o_b), sf, sb


def _gated_out(o, z, w):
    bn, t = o.shape[0], o.shape[1]
    on = _rmsnorm(o, w)
    zf = jax.nn.silu(z.astype(jnp.float32)).reshape(bn, t, A_HEADS, A_DV)
    return (on * zf).reshape(bn, t, A_W).astype(z.dtype)


def _attend_dense(q, k, v, sink):
    bn, t, hq, hd = q.shape
    kv = k.shape[2]
    grp = hq // kv
    nb = t // QBLOCK
    scale = hd ** -0.5
    qb = q.reshape(bn, nb, QBLOCK, kv, grp, hd).transpose(1, 0, 2, 3, 4, 5)

    def blk(qi):
        s = jnp.einsum('bqkgd,bskd->bkgqs', qi, k).astype(jnp.float32) * scale
        if sink is not None:
            sk = jnp.broadcast_to(sink.astype(jnp.float32).reshape(kv, grp)[None, :, :, None, None],
                                  s.shape[:-1] + (1,))
            s = jnp.concatenate([s, sk], axis=-1)
        p = jax.nn.softmax(s, axis=-1)
        if sink is not None:
            p = p[..., :-1]
        o = jnp.einsum('bkgqs,bskd->bqkgd', p.astype(v.dtype), v)
        return o.reshape(bn, QBLOCK, hq * hd)

    out = lax.map(blk, qb)
    return out.transpose(1, 0, 2, 3).reshape(bn, t, hq * hd)


def _attend_window(q, k, v, k_ctx, v_ctx, sink):
    bn, t, hq, hd = q.shape
    kv = k.shape[2]
    grp = hq // kv
    nb = t // QBLOCK
    n_ctx = k_ctx.shape[1]
    span = QBLOCK + 2 * WINDOW
    scale = hd ** -0.5
    pad = ((0, 0), (WINDOW, WINDOW), (0, 0), (0, 0))
    kp, vp = jnp.pad(k, pad), jnp.pad(v, pad)
    qb = q.reshape(bn, nb, QBLOCK, kv, grp, hd).transpose(1, 0, 2, 3, 4, 5)
    rel = (jnp.arange(span) - WINDOW)[None, :] - jnp.arange(QBLOCK)[:, None]
    band = jnp.abs(rel) <= WINDOW
    sink_l = sink.astype(jnp.float32).reshape(kv, grp)[None, :, :, None, None]

    def blk(args):
        qi, bi = args
        start = bi * QBLOCK
        kb = lax.dynamic_slice_in_dim(kp, start, span, axis=1)
        vb = lax.dynamic_slice_in_dim(vp, start, span, axis=1)
        kpos = start - WINDOW + jnp.arange(span)
        mask = band & ((kpos >= 0) & (kpos < t))[None, :]
        s_ctx = jnp.einsum('bqkgd,bskd->bkgqs', qi, k_ctx).astype(jnp.float32) * scale
        s_loc = jnp.einsum('bqkgd,bskd->bkgqs', qi, kb).astype(jnp.float32) * scale
        s_loc = jnp.where(mask, s_loc, -1e30)
        s_snk = jnp.broadcast_to(sink_l, s_ctx.shape[:-1] + (1,))
        p = jax.nn.softmax(jnp.concatenate([s_ctx, s_loc, s_snk], axis=-1), axis=-1)
        o = (jnp.einsum('bkgqs,bskd->bqkgd', p[..., :n_ctx].astype(v.dtype), v_ctx)
             + jnp.einsum('bkgqs,bskd->bqkgd', p[..., n_ctx:n_ctx + span].astype(v.dtype), vb))
        return o.reshape(bn, QBLOCK, hq * hd)

    out = lax.map(blk, (qb, jnp.arange(nb)))
    return out.transpose(1, 0, 2, 3).reshape(bn, t, hq * hd)


def _mixers_in(h, p):
    (a_qkv, a_z, a_beta, a_alpha, b_q, b_k, b_v, c_q, c_k, c_v, gates) = _split_cols(h @ p['w_in'])
    gdn = _gdn_features(a_qkv, a_beta, a_alpha, p['conv_qkv'], p['a_log'], p['dt_bias'])
    qn = p['qk_norm']
    att_b = (_rmsnorm(_heads(b_q, B_HEADS), qn[0]), _rmsnorm(_heads(b_k, B_KV), qn[1]), _heads(b_v, B_KV))
    att_c = (_rmsnorm(_heads(c_q, C_HEADS), qn[2]), _rmsnorm(_heads(c_k, C_KV), qn[3]), _heads(c_v, C_KV))
    return gdn, a_z, att_b, att_c, gates


def _mixers_out(x, ya, yb, yc, gates, gate1, shift2, scale2, gate2, p):
    ga, gb, gc = jnp.split(jax.nn.sigmoid(gates), 3, axis=-1)
    merged = ga * (ya @ p['w_br_a']) + gb * (yb @ p['w_br_b']) + gc * (yc @ p['w_br_c'])
    x = x + gate1 * (merged @ p['w_o'])
    h2 = _mod_norm(x, p['ln2'], shift2, scale2)
    return x + gate2 * (jnp.square(jax.nn.relu(h2 @ p['w_ff1'])) @ p['w_ff2'])


def _context_layer(x, mod, p):
    sh1, sc1, g1, sh2, sc2, g2 = jnp.split(mod, 6, axis=-1)
    h = _mod_norm(x, p['ln1'], sh1, sc1)
    (q, k, v, beta, g), a_z, (qb, kb, vb), (qc, kc, vc), gates = _mixers_in(h, p)
    zero = jnp.zeros((x.shape[0], A_HEADS, A_DK, A_DV), jnp.float32)
    oa, s_f, s_b = _gdn_bidir(q, k, v, beta, g, zero, zero)
    ya = _gated_out(oa, a_z, p['a_norm'])
    yb = _attend_dense(qb, kb, vb, None)
    yc = _attend_dense(qc, kc, vc, p['sink'])
    x = _mixers_out(x, ya, yb, yc, gates, g1, sh2, sc2, g2, p)
    return x, kb, vb, kc, vc, jnp.stack([s_f, s_b], axis=1).astype(x.dtype)


def _latent_layer(x, mod, p, cos, sin, k_glob, v_glob, k_win, v_win, s_ctx):
    sh1, sc1, g1, sh2, sc2, g2 = jnp.split(mod, 6, axis=-1)
    h = _mod_norm(x, p['ln1'], sh1, sc1)
    (q, k, v, beta, g), a_z, (qb, kb, vb), (qc, kc, vc), gates = _mixers_in(h, p)
    oa, _, _ = _gdn_bidir(q, k, v, beta, g, s_ctx[:, 0], s_ctx[:, 1])
    ya = _gated_out(oa, a_z, p['a_norm'])
    qb, kb = _rope(qb, cos, sin), _rope(kb, cos, sin)
    yb = _attend_dense(qb, jnp.concatenate([k_glob, kb], axis=1), jnp.concatenate([v_glob, vb], axis=1), None)
    qc, kc = _rope(qc, cos, sin), _rope(kc, cos, sin)
    yc = _attend_window(qc, kc, vc, k_win, v_win, p['sink'])
    return _mixers_out(x, ya, yb, yc, gates, g1, sh2, sc2, g2, p)


def setup_inputs(seed: int = 0) -> dict:
    key = jax.random.key(seed)
    ks = jax.random.split(key, 26)
    f32 = jnp.float32

    def nrm(k, shape, scale):
        return scale * jax.random.normal(k, shape, f32)

    dt = jnp.exp(jax.random.uniform(ks[13], (DEPTH, 2, A_HEADS), f32, math.log(1e-3), math.log(1e-1)))
    dt_bias = dt + jnp.log(-jnp.expm1(-dt))
    a_log = jnp.log(jax.random.uniform(ks[14], (DEPTH, 2, A_HEADS), f32, 1.0, 16.0))
    return {
        'x_prompt': nrm(ks[0], (BATCH, SEQ, D_MODEL), 1.0),
        'x_sample': nrm(ks[1], (DEC_BATCH, DEC_SEQ, D_MODEL), 1.0),
        'cache_k_glob': nrm(ks[2], (DEC_BATCH, DEPTH, PAST_LEN, B_KV, HEAD_DIM), 1.0),
        'cache_v_glob': nrm(ks[3], (DEC_BATCH, DEPTH, PAST_LEN, B_KV, HEAD_DIM), 1.0),
        'cache_k_win': nrm(ks[4], (DEC_BATCH, DEPTH, PAST_LEN, C_KV, HEAD_DIM), 1.0),
        'cache_v_win': nrm(ks[5], (DEC_BATCH, DEPTH, PAST_LEN, C_KV, HEAD_DIM), 1.0),
        'state_delta': nrm(ks[6], (DEC_BATCH, DEPTH, 2, A_HEADS, A_DK, A_DV), A_DK ** -0.5),
        'c': nrm(ks[7], (DEC_BATCH, D_MODEL), 1.0),
        'c_ctx': nrm(ks[8], (D_MODEL,), 1.0),
        'w_mod': nrm(ks[9], (DEPTH, D_MODEL, 6 * D_MODEL), 0.5 * D_MODEL ** -0.5),
        'b_mod': nrm(ks[10], (DEPTH, 6 * D_MODEL), 0.02),
        'ln1': 1.0 + nrm(ks[11], (DEPTH, D_MODEL), 0.02),
        'ln2': 1.0 + nrm(ks[12], (DEPTH, D_MODEL), 0.02),
        'w_in': nrm(ks[15], (DEPTH, D_MODEL, IN_COLS), D_MODEL ** -0.5),
        'conv_qkv': nrm(ks[16], (DEPTH, CONV_K, 3 * A_W), CONV_K ** -0.5),
        'a_log': a_log,
        'dt_bias': dt_bias,
        'a_norm': 1.0 + nrm(ks[17], (DEPTH, A_DV), 0.02),
        'qk_norm': 1.0 + nrm(ks[18], (DEPTH, 4, HEAD_DIM), 0.02),
        'sink': nrm(ks[19], (DEPTH, C_HEADS), 0.5),
        'w_br_a': nrm(ks[20], (DEPTH, A_W, D_MODEL), A_W ** -0.5),
        'w_br_b': nrm(ks[21], (DEPTH, B_HEADS * HEAD_DIM, D_MODEL), (B_HEADS * HEAD_DIM) ** -0.5),
        'w_br_c': nrm(ks[22], (DEPTH, C_HEADS * HEAD_DIM, D_MODEL), (C_HEADS * HEAD_DIM) ** -0.5),
        'w_o': nrm(ks[23], (DEPTH, D_MODEL, D_MODEL), D_MODEL ** -0.5),
        'w_ff1': nrm(ks[24], (DEPTH, D_MODEL, D_FF), D_MODEL ** -0.5),
        'w_ff2': nrm(ks[25], (DEPTH, D_FF, D_MODEL), D_FF ** -0.5),
    }


def reference(x_prompt, x_sample, cache_k_glob, cache_v_glob, cache_k_win, cache_v_win, state_delta, c,
              c_ctx, w_mod, b_mod, ln1, ln2, w_in, conv_qkv, a_log, dt_bias, a_norm, qk_norm, sink,
              w_br_a, w_br_b, w_br_c, w_o, w_ff1, w_ff2):
    cos, sin = _axial_rope_tables(x_sample.shape[1])
    xp, xs = x_prompt, x_sample
    new_kg, new_vg, new_kw, new_vw, new_st = [], [], [], [], []
    for l in range(DEPTH):
        p = dict(ln1=ln1[l], ln2=ln2[l], w_in=w_in[l], conv_qkv=conv_qkv[l], a_log=a_log[l],
                 dt_bias=dt_bias[l], a_norm=a_norm[l], qk_norm=qk_norm[l], sink=sink[l],
                 w_br_a=w_br_a[l], w_br_b=w_br_b[l], w_br_c=w_br_c[l], w_o=w_o[l],
                 w_ff1=w_ff1[l], w_ff2=w_ff2[l])
        mod_ctx = jax.nn.silu(c_ctx) @ w_mod[l] + b_mod[l]
        mod_lat = (jax.nn.silu(c) @ w_mod[l] + b_mod[l])[:, None, :]
        xp, kb, vb, kc, vc, st = _context_layer(xp, mod_ctx, p)
        new_kg.append(kb)
        new_vg.append(vb)
        new_kw.append(kc)
        new_vw.append(vc)
        new_st.append(st)
        xs = _latent_layer(xs, mod_lat, p, cos, sin, cache_k_glob[:, l], cache_v_glob[:, l],
                           cache_k_win[:, l], cache_v_win[:, l], state_delta[:, l])
    return (xp, xs, jnp.stack(new_kg, axis=1), jnp.stack(new_vg, axis=1), jnp.stack(new_kw, axis=1),
            jnp.stack(new_vw, axis=1), jnp.stack(new_st, axis=1))
```

```cpp
#include <hip/hip_runtime.h>
#include <hip/hip_cooperative_groups.h>
#include <stdint.h>
#include <stdio.h>
#include <string.h>
namespace cg = cooperative_groups;

#ifndef MEGA
#define MEGA 0
#endif

typedef unsigned short bf16_t;
typedef __attribute__((ext_vector_type(8))) short bf16x8;
typedef __attribute__((ext_vector_type(4))) short bf16x4;
typedef __attribute__((ext_vector_type(4))) float f32x4;
#define DI __device__ __forceinline__
#define MFMA16(a, b, c) __builtin_amdgcn_mfma_f32_16x16x32_bf16((a), (b), (c), 0, 0, 0)

constexpr int NTOK = 12288, NCTX = 4096, DM = 1024, NCOLP = 6784, INCOLS = 6688, DFF = 4096;
constexpr int LFULL = 4608;
constexpr float EPS = 1e-6f;
constexpr size_t OUT_KG = 12582912, OUT_VG = 14680064, OUT_KW = 16777216, OUT_VW = 18874368, OUT_ST = 20971520;
constexpr int SMEM_BYTES = 73728;

struct Params {
  const float *x_prompt, *x_sample, *ckg, *cvg, *ckw, *cvw, *state, *c, *c_ctx, *w_mod, *b_mod, *ln1, *ln2, *w_in, *conv,
      *a_log, *dt_bias, *a_norm, *qk_norm, *sink, *w_br_a, *w_br_b, *w_br_c, *w_o, *w_ff1, *w_ff2;
  float* out;
  bf16_t *wt_in, *wt_br, *wt_o, *wt_ff1, *wt_ff2;
  float *mods, *ropec, *ropes;
  unsigned* counters;
  bf16_t* h;
  bf16_t *qkv_raw, *z, *qB, *qC, *gates;
  float *ba, *bg;
  bf16_t *fq, *fk, *fv;
  bf16_t *kfB, *vtfB, *kfC, *vtfC;
  bf16_t *kcB, *vtcB, *kcC, *vtcC;
  float *of, *ob;
  bf16_t *ya, *yb, *yc;
  bf16_t* f;
};

DI float bf2f(bf16_t x) { return __uint_as_float(((unsigned)x) << 16); }
DI bf16_t f2bf(float f) { unsigned u = __float_as_uint(f); u += 0x7fffu + ((u >> 16) & 1u); return (bf16_t)(u >> 16); }
DI unsigned pack2(float a, float b) { return (unsigned)f2bf(a) | ((unsigned)f2bf(b) << 16); }
DI float wave_sum(float v) {
#pragma unroll
  for (int o = 32; o > 0; o >>= 1) v += __shfl_xor(v, o);
  return v;
}
DI float sigmoidf_(float x) { return 1.f / (1.f + __expf(-x)); }
DI float siluf_(float x) { return x / (1.f + __expf(-x)); }
DI int mod_index(int n) { return n < NCTX ? 0 : 1 + ((n - NCTX) >> 12); }

constexpr int PREP_MODS = 384, PREP_TRL = 4384, PREP_TR = 4 * PREP_TRL, PREP_XC = 768, PREP_ROPE = 32, PREP_MISC = 1;
constexpr int PREP_N = PREP_MODS + PREP_TR + PREP_XC + PREP_ROPE + PREP_MISC;

DI void tr_tile(const float* __restrict__ src, int ldsrc, int srccol0, int nvalid, bf16_t* __restrict__ dst, int ldd, int n0, int k0, float* tile) {
  const int tid = threadIdx.x;
  {
    const int nn = tid & 63;
#pragma unroll 4
    for (int i = 0; i < 16; i++) {
      const int kk = (tid >> 6) + 4 * i;
      float v = 0.f;
      if (nn < nvalid) v = src[(size_t)(k0 + kk) * ldsrc + srccol0 + nn];
      tile[kk * 65 + nn] = v;
    }
  }
  __syncthreads();
  {
    const int kk = tid & 63;
#pragma unroll 4
    for (int i = 0; i < 16; i++) {
      const int nn = (tid >> 6) + 4 * i;
      dst[(size_t)(n0 + nn) * ldd + k0 + kk] = f2bf(tile[kk * 65 + nn]);
    }
  }
  __syncthreads();
}

DI void prep_item(const Params& P, int item, char* smem) {
  const int tid = threadIdx.x, lane = tid & 63, wid = tid >> 6;
  float* sm = (float*)smem;
  if (item < PREP_MODS) {
    const int l = item / 96, jb = item % 96;
    float* ssil = sm;
    float* red = sm + 3072;
    for (int k = tid; k < 1024; k += 256) {
      ssil[k] = siluf_(P.c_ctx[k]);
      ssil[1024 + k] = siluf_(P.c[k]);
      ssil[2048 + k] = siluf_(P.c[1024 + k]);
    }
    __syncthreads();
    const float* W = P.w_mod + (size_t)l * 1024 * 6144 + jb * 64 + lane;
    float a0 = 0.f, a1 = 0.f, a2 = 0.f;
    const int kb = wid * 256;
#pragma unroll 8
    for (int k = 0; k < 256; k++) {
      const float w = W[(size_t)(kb + k) * 6144];
      a0 += ssil[kb + k] * w; a1 += ssil[1024 + kb + k] * w; a2 += ssil[2048 + kb + k] * w;
    }
    red[(wid * 3 + 0) * 64 + lane] = a0; red[(wid * 3 + 1) * 64 + lane] = a1; red[(wid * 3 + 2) * 64 + lane] = a2;
    __syncthreads();
    if (tid < 192) {
      const int m = tid >> 6, jj = tid & 63;
      float s = 0.f;
      for (int w = 0; w < 4; w++) s += red[(w * 3 + m) * 64 + jj];
      P.mods[((size_t)l * 3 + m) * 6144 + jb * 64 + jj] = s + P.b_mod[(size_t)l * 6144 + jb * 64 + jj];
    }
    __syncthreads();
    return;
  }
  item -= PREP_MODS;
  if (item < PREP_TR) {
    const int l = item / PREP_TRL; int s = item % PREP_TRL;
    if (s < 1696) {
      const int nt = s / 16, kt = s % 16;
      int srccol0 = nt * 64, nvalid = 64;
      if (nt == 32) { srccol0 = 2048; nvalid = 32; } else if (nt > 32 && nt < 105) { srccol0 = nt * 64 - 32; } else if (nt >= 105) { nvalid = 0; srccol0 = 0; }
      tr_tile(P.w_in + (size_t)l * 1024 * INCOLS, INCOLS, srccol0, nvalid, P.wt_in + (size_t)l * NCOLP * 1024, 1024, nt * 64, kt * 64, sm);
      return;
    }
    s -= 1696;
    if (s < 384) {
      const int which = s / 128, r = s % 128, nt = r / 8, kt = r % 8;
      const float* src = (which == 0 ? P.w_br_a : which == 1 ? P.w_br_b : P.w_br_c) + (size_t)l * 512 * 1024;
      tr_tile(src, 1024, nt * 64, 64, P.wt_br + (size_t)(l * 3 + which) * 1024 * 512, 512, nt * 64, kt * 64, sm);
      return;
    }
    s -= 384;
    if (s < 256) {
      const int nt = s / 16, kt = s % 16;
      tr_tile(P.w_o + (size_t)l * 1024 * 1024, 1024, nt * 64, 64, P.wt_o + (size_t)l * 1024 * 1024, 1024, nt * 64, kt * 64, sm);
      return;
    }
    s -= 256;
    if (s < 1024) {
      const int nt = s / 16, kt = s % 16;
      tr_tile(P.w_ff1 + (size_t)l * 1024 * 4096, 4096, nt * 64, 64, P.wt_ff1 + (size_t)l * 4096 * 1024, 1024, nt * 64, kt * 64, sm);
      return;
    }
    s -= 1024;
    {
      const int nt = s / 64, kt = s % 64;
      tr_tile(P.w_ff2 + (size_t)l * 4096 * 1024, 1024, nt * 64, 64, P.wt_ff2 + (size_t)l * 1024 * 4096, 4096, nt * 64, kt * 64, sm);
      return;
    }
  }
  item -= PREP_TR;
  if (item < PREP_XC) {
    const size_t base = (size_t)item * 16384;
    const float4* src = (const float4*)(base < 4194304 ? P.x_prompt + base : P.x_sample + (base - 4194304));
    float4* dst = (float4*)(P.out + base);
#pragma unroll 4
    for (int i = 0; i < 16; i++) dst[tid + 256 * i] = src[tid + 256 * i];
    return;
  }
  item -= PREP_XC;
  if (item < PREP_ROPE) {
    for (int i = 0; i < 16; i++) {
      const int e = item * 4096 + tid + 256 * i;
      const int t = e >> 5, i2 = e & 31;
      const int pos = (i2 < 16) ? (t >> 6) : (t & 63);
      const int fi = i2 & 15;
      const float inv = exp2f(-(float)fi * (13.287712379549449f / 16.f));
      const float ang = (float)pos * inv;
      P.ropec[e] = cosf(ang);
      P.ropes[e] = sinf(ang);
    }
    return;
  }
  item -= PREP_ROPE;
  if (tid < 64) P.counters[tid] = 0u;
}

constexpr int NORM_ROWS = NTOK / 4;
constexpr int NORM1_N = NORM_ROWS + 32;

DI void modnorm_item(const Params& P, int l, int which, int item) {
  const int tid = threadIdx.x, lane = tid & 63, wid = tid >> 6;
  const int n = item * 4 + wid;
  const float* xr = P.out + (size_t)n * DM;
  float4 v[4];
  float ss = 0.f;
#pragma unroll
  for (int i = 0; i < 4; i++) { v[i] = *(const float4*)(xr + lane * 4 + 256 * i); ss += v[i].x * v[i].x + v[i].y * v[i].y + v[i].z * v[i].z + v[i].w * v[i].w; }
  ss = wave_sum(ss);
  const float rstd = rsqrtf(ss * (1.f / 1024.f) + EPS);
  const float* md = P.mods + ((size_t)l * 3 + mod_index(n)) * 6144;
  const float* sh = md + (which ? 3072 : 0);
  const float* sc = md + (which ? 4096 : 1024);
  const float* lw = (which ? P.ln2 : P.ln1) + (size_t)l * DM;
#pragma unroll
  for (int i = 0; i < 4; i++) {
    const int c = lane * 4 + 256 * i;
    const float4 w4 = *(const float4*)(lw + c), s4 = *(const float4*)(sc + c), h4 = *(const float4*)(sh + c);
    const float y0 = v[i].x * rstd * w4.x * (1.f + s4.x) + h4.x;
    const float y1 = v[i].y * rstd * w4.y * (1.f + s4.y) + h4.y;
    const float y2 = v[i].z * rstd * w4.z * (1.f + s4.z) + h4.z;
    const float y3 = v[i].w * rstd * w4.w * (1.f + s4.w) + h4.w;
    uint2 o; o.x = pack2(y0, y1); o.y = pack2(y2, y3);
    *(uint2*)(P.h + (size_t)n * DM + c) = o;
  }
}

DI void cache_item(const Params& P, int l, int item) {
  const int tid = threadIdx.x;
  const int type = item >> 4, b = (item >> 3) & 1, pb = item & 7;
  const float* ck = type ? P.ckw : P.ckg;
  const float* cv = type ? P.cvw : P.cvg;
  bf16_t* kf = type ? P.kfC : P.kfB;
  bf16_t* vtf = type ? P.vtfC : P.vtfB;
  for (int i = 0; i < 32; i++) {
    const int e = tid + 256 * i;
    const int pl = e >> 7, c = e & 127, kvh = c >> 6, d = c & 63;
    const int pos = pb * 64 + pl;
    const size_t si = ((((size_t)b * 4 + l) * 512 + pos) * 2 + kvh) * 64 + d;
    kf[((size_t)(b * 2 + kvh) * LFULL + pos) * 64 + d] = f2bf(ck[si]);
    vtf[((size_t)(b * 2 + kvh) * 64 + d) * LFULL + pos] = f2bf(cv[si]);
  }
}

template <int NI>
DI void gemm_mainloop(const bf16_t* __restrict__ A, int lda, const bf16_t* __restrict__ Bt, int ldb, int K, int m0, int n0, bf16_t* sm, f32x4 (&acc)[4][NI]) {
  const int tid = threadIdx.x, lane = tid & 63, wid = tid >> 6, wm = wid >> 1, wn = wid & 1, lr = lane & 15, quad = lane >> 4;
  const int ldr = tid >> 3, ldc = (tid & 7) * 8;
  const bf16_t* ga = A + (size_t)(m0 + ldr) * lda + ldc;
  const bf16_t* gb = Bt + (size_t)(n0 + ldr) * ldb + ldc;
  uint4 ra[4], rb[NI];
#pragma unroll
  for (int i = 0; i < 4; i++) ra[i] = *(const uint4*)(ga + (size_t)i * 32 * lda);
#pragma unroll
  for (int i = 0; i < NI; i++) rb[i] = *(const uint4*)(gb + (size_t)i * 32 * ldb);
#pragma unroll
  for (int i = 0; i < 4; i++) *(uint4*)(sm + (ldr + 32 * i) * 72 + ldc) = ra[i];
#pragma unroll
  for (int i = 0; i < NI; i++) *(uint4*)(sm + 9216 + (ldr + 32 * i) * 72 + ldc) = rb[i];
  __syncthreads();
  const int nk = K >> 6;
  for (int kt = 0; kt < nk; kt++) {
    const int cur = kt & 1;
    if (kt + 1 < nk) {
      const int ko = (kt + 1) * 64;
#pragma unroll
      for (int i = 0; i < 4; i++) ra[i] = *(const uint4*)(ga + (size_t)i * 32 * lda + ko);
#pragma unroll
      for (int i = 0; i < NI; i++) rb[i] = *(const uint4*)(gb + (size_t)i * 32 * ldb + ko);
    }
    const bf16_t* cA = sm + cur * 18432 + (wm * 64 + lr) * 72 + quad * 8;
    const bf16_t* cB = sm + cur * 18432 + 9216 + (wn * 16 * NI + lr) * 72 + quad * 8;
#pragma unroll
    for (int ks = 0; ks < 2; ks++) {
      bf16x8 af[4], bfr[NI];
#pragma unroll
      for (int mi = 0; mi < 4; mi++) af[mi] = *(const bf16x8*)(cA + mi * 16 * 72 + ks * 32);
#pragma unroll
      for (int ni = 0; ni < NI; ni++) bfr[ni] = *(const bf16x8*)(cB + ni * 16 * 72 + ks * 32);
#pragma unroll
      for (int mi = 0; mi < 4; mi++)
#pragma unroll
        for (int ni = 0; ni < NI; ni++) acc[mi][ni] = MFMA16(af[mi], bfr[ni], acc[mi][ni]);
    }
    if (kt + 1 < nk) {
      bf16_t* nb = sm + (cur ^ 1) * 18432;
#pragma unroll
      for (int i = 0; i < 4; i++) *(uint4*)(nb + (ldr + 32 * i) * 72 + ldc) = ra[i];
#pragma unroll
      for (int i = 0; i < NI; i++) *(uint4*)(nb + 9216 + (ldr + 32 * i) * 72 + ldc) = rb[i];
    }
    __syncthreads();
  }
}

template <int NI>
DI void zero_acc(f32x4 (&acc)[4][NI]) {
#pragma unroll
  for (int i = 0; i < 4; i++)
#pragma unroll
    for (int j = 0; j < NI; j++) acc[i][j] = (f32x4){0.f, 0.f, 0.f, 0.f};
}

constexpr int GEMM_IN_N = 96 * 53;

DI void gemm_in_item(const Params& P, int l, int item, char* smem) {
  const int mt = item % 96, nt = item / 96;
  const int m0 = mt * 128, n0 = nt * 128;
  f32x4 acc[4][4];
  zero_acc<4>(acc);
  gemm_mainloop<4>(P.h, DM, P.wt_in + (size_t)l * NCOLP * 1024, 1024, 1024, m0, n0, (bf16_t*)smem, acc);
  const int tid = threadIdx.x, lane = tid & 63, wid = tid >> 6, wm = wid >> 1, wn = wid & 1, lr = lane & 15, quad = lane >> 4;
  const int row0 = m0 + wm * 64, col0 = n0 + wn * 64;
  const int w64 = col0 >> 6;
  if (w64 < 24) {
#pragma unroll
    for (int mi = 0; mi < 4; mi++)
#pragma unroll
      for (int j = 0; j < 4; j++) {
        const size_t row = row0 + mi * 16 + quad * 4 + j;
#pragma unroll
        for (int ni = 0; ni < 4; ni++) P.qkv_raw[row * 1536 + w64 * 64 + ni * 16 + lr] = f2bf(acc[mi][ni][j]);
      }
  } else if (w64 < 32) {
#pragma unroll
    for (int mi = 0; mi < 4; mi++)
#pragma unroll
      for (int j = 0; j < 4; j++) {
        const size_t row = row0 + mi * 16 + quad * 4 + j;
#pragma unroll
        for (int ni = 0; ni < 4; ni++) P.z[row * 512 + (w64 - 24) * 64 + ni * 16 + lr] = f2bf(acc[mi][ni][j]);
      }
  } else if (w64 == 32) {
#pragma unroll
    for (int mi = 0; mi < 4; mi++)
#pragma unroll
      for (int j = 0; j < 4; j++) {
        const size_t row = row0 + mi * 16 + quad * 4 + j;
#pragma unroll
        for (int ni = 0; ni < 2; ni++) P.ba[row * 32 + ni * 16 + lr] = acc[mi][ni][j];
      }
  } else if (w64 < 57) {
    const int hidx = w64 - 33;
    const int typeC = hidx >= 12;
    const int hh = typeC ? hidx - 12 : hidx;
    const bool isq = hh < 8, isk = (hh == 8 || hh == 9), isv = hh >= 10;
    const int kvh = isk ? hh - 8 : (isv ? hh - 10 : 0);
    const bool latent = row0 >= NCTX;
    const float* qn = P.qk_norm + ((size_t)l * 4 + (typeC ? 2 : 0) + (isk ? 1 : 0)) * 64;
    float qw[4];
#pragma unroll
    for (int ni = 0; ni < 4; ni++) qw[ni] = qn[ni * 16 + lr];
#pragma unroll
    for (int mi = 0; mi < 4; mi++)
#pragma unroll
      for (int j = 0; j < 4; j++) {
        const int row = row0 + mi * 16 + quad * 4 + j;
        float val[4];
#pragma unroll
        for (int ni = 0; ni < 4; ni++) val[ni] = acc[mi][ni][j];
        if (!isv) {
          float ss = val[0] * val[0] + val[1] * val[1] + val[2] * val[2] + val[3] * val[3];
          ss += __shfl_xor(ss, 1); ss += __shfl_xor(ss, 2); ss += __shfl_xor(ss, 4); ss += __shfl_xor(ss, 8);
          const float rstd = rsqrtf(ss * (1.f / 64.f) + EPS);
#pragma unroll
          for (int ni = 0; ni < 4; ni++) val[ni] = val[ni] * rstd * qw[ni];
        }
        if (!latent) {
          const int b = row >> 8, t = row & 255;
          if (isq) {
            bf16_t* q = (typeC ? P.qC : P.qB) + (size_t)row * 512 + hh * 64;
#pragma unroll
            for (int ni = 0; ni < 4; ni++) q[ni * 16 + lr] = f2bf(val[ni] * 0.125f);
          } else if (isk) {
            bf16_t* kc = (typeC ? P.kcC : P.kcB) + ((size_t)(b * 2 + kvh) * 256 + t) * 64;
            float* ko = P.out + (typeC ? OUT_KW : OUT_KG) + (((size_t)(b * 4 + l) * 256 + t) * 2 + kvh) * 64;
#pragma unroll
            for (int ni = 0; ni < 4; ni++) { kc[ni * 16 + lr] = f2bf(val[ni]); ko[ni * 16 + lr] = val[ni]; }
          } else {
            bf16_t* vt = (typeC ? P.vtcC : P.vtcB) + (size_t)(b * 2 + kvh) * 64 * 256 + t;
            float* vo = P.out + (typeC ? OUT_VW : OUT_VG) + (((size_t)(b * 4 + l) * 256 + t) * 2 + kvh) * 64;
#pragma unroll
            for (int ni = 0; ni < 4; ni++) { vt[(size_t)(ni * 16 + lr) * 256] = f2bf(val[ni]); vo[ni * 16 + lr] = val[ni]; }
          }
        } else {
          const int b = (row - NCTX) >> 12, t = (row - NCTX) & 4095;
          if (!isv) {
            const float c0 = P.ropec[t * 32 + lr], c1 = P.ropec[t * 32 + 16 + lr];
            const float s0 = P.ropes[t * 32 + lr], s1 = P.ropes[t * 32 + 16 + lr];
            const float x10 = val[0], x11 = val[1], x20 = val[2], x21 = val[3];
            val[0] = x10 * c0 - x20 * s0; val[2] = x20 * c0 + x10 * s0;
            val[1] = x11 * c1 - x21 * s1; val[3] = x21 * c1 + x11 * s1;
          }
          if (isq) {
            bf16_t* q = (typeC ? P.qC : P.qB) + (size_t)row * 512 + hh * 64;
#pragma unroll
            for (int ni = 0; ni < 4; ni++) q[ni * 16 + lr] = f2bf(val[ni] * 0.125f);
          } else if (isk) {
            bf16_t* kf = (typeC ? P.kfC : P.kfB) + ((size_t)(b * 2 + kvh) * LFULL + 512 + t) * 64;
#pragma unroll
            for (int ni = 0; ni < 4; ni++) kf[ni * 16 + lr] = f2bf(val[ni]);
          } else {
            bf16_t* vt = (typeC ? P.vtfC : P.vtfB) + (size_t)(b * 2 + kvh) * 64 * LFULL + 512 + t;
#pragma unroll
            for (int ni = 0; ni < 4; ni++) vt[(size_t)(ni * 16 + lr) * LFULL] = f2bf(val[ni]);
          }
        }
      }
  } else if (w64 < 105) {
#pragma unroll
    for (int mi = 0; mi < 4; mi++)
#pragma unroll
      for (int j = 0; j < 4; j++) {
        const size_t row = row0 + mi * 16 + quad * 4 + j;
#pragma unroll
        for (int ni = 0; ni < 4; ni++) P.gates[row * 3072 + (w64 - 57) * 64 + ni * 16 + lr] = f2bf(sigmoidf_(acc[mi][ni][j]));
      }
  }
}

constexpr int GEMM_D_N = 96 * 8;
constexpr int GEMM_BR_N = 96 * 16;

DI void gemm_br_item(const Params& P, int l, int item, char* smem) {
  const int mt = item % 96, nt = item / 96;
  const int m0 = mt * 128, n0 = nt * 64;
  const int tid = threadIdx.x, lane = tid & 63, wid = tid >> 6, wm = wid >> 1, wn = wid & 1, lr = lane & 15, quad = lane >> 4;
  const int row0 = m0 + wm * 64, col0 = n0 + wn * 32;
  f32x4 tot[4][2];
  zero_acc<2>(tot);
#pragma unroll 1
  for (int br = 0; br < 3; br++) {
    f32x4 acc[4][2];
    zero_acc<2>(acc);
    const bf16_t* A = br == 0 ? P.ya : br == 1 ? P.yb : P.yc;
    gemm_mainloop<2>(A, 512, P.wt_br + (size_t)(l * 3 + br) * 1024 * 512, 512, 512, m0, n0, (bf16_t*)smem, acc);
#pragma unroll
    for (int mi = 0; mi < 4; mi++)
#pragma unroll
      for (int j = 0; j < 4; j++) {
        const size_t row = row0 + mi * 16 + quad * 4 + j;
#pragma unroll
        for (int ni = 0; ni < 2; ni++) tot[mi][ni][j] += bf2f(P.gates[row * 3072 + br * 1024 + col0 + ni * 16 + lr]) * acc[mi][ni][j];
      }
  }
#pragma unroll
  for (int mi = 0; mi < 4; mi++)
#pragma unroll
    for (int j = 0; j < 4; j++) {
      const size_t row = row0 + mi * 16 + quad * 4 + j;
#pragma unroll
      for (int ni = 0; ni < 2; ni++) P.h[row * DM + col0 + ni * 16 + lr] = f2bf(tot[mi][ni][j]);
    }
}

DI void gemm_res_item(const Params& P, int l, int item, char* smem, const bf16_t* A, int K, const bf16_t* Bt, int gate_off) {
  const int mt = item % 96, nt = item / 96;
  const int m0 = mt * 128, n0 = nt * 128;
  f32x4 acc[4][4];
  zero_acc<4>(acc);
  gemm_mainloop<4>(A, K, Bt, K, K, m0, n0, (bf16_t*)smem, acc);
  const int tid = threadIdx.x, lane = tid & 63, wid = tid >> 6, wm = wid >> 1, wn = wid & 1, lr = lane & 15, quad = lane >> 4;
  const int row0 = m0 + wm * 64, col0 = n0 + wn * 64;
  const float* g = P.mods + ((size_t)l * 3 + mod_index(row0)) * 6144 + gate_off + col0;
  float gv[4];
#pragma unroll
  for (int ni = 0; ni < 4; ni++) gv[ni] = g[ni * 16 + lr];
#pragma unroll
  for (int mi = 0; mi < 4; mi++)
#pragma unroll
    for (int j = 0; j < 4; j++) {
      const size_t row = row0 + mi * 16 + quad * 4 + j;
#pragma unroll
      for (int ni = 0; ni < 4; ni++) {
        float* xp = P.out + row * DM + col0 + ni * 16 + lr;
        *xp = *xp + gv[ni] * acc[mi][ni][j];
      }
    }
}

constexpr int GEMM_FF1_N = 96 * 32;
DI void gemm_ff1_item(const Params& P, int l, int item, char* smem) {
  const int mt = item % 96, nt = item / 96;
  const int m0 = mt * 128, n0 = nt * 128;
  f32x4 acc[4][4];
  zero_acc<4>(acc);
  gemm_mainloop<4>(P.h, DM, P.wt_ff1 + (size_t)l * DFF * 1024, 1024, 1024, m0, n0, (bf16_t*)smem, acc);
  const int tid = threadIdx.x, lane = tid & 63, wid = tid >> 6, wm = wid >> 1, wn = wid & 1, lr = lane & 15, quad = lane >> 4;
  const int row0 = m0 + wm * 64, col0 = n0 + wn * 64;
#pragma unroll
  for (int mi = 0; mi < 4; mi++)
#pragma unroll
    for (int j = 0; j < 4; j++) {
      const size_t row = row0 + mi * 16 + quad * 4 + j;
#pragma unroll
      for (int ni = 0; ni < 4; ni++) {
        const float r = fmaxf(acc[mi][ni][j], 0.f);
        P.f[row * DFF + col0 + ni * 16 + lr] = f2bf(r * r);
      }
    }
}

DI void feat_item(const Params& P, int l, int n) {
  const int tid = threadIdx.x;
  int s0, s1;
  if (n < NCTX) { s0 = n & ~255; s1 = s0 + 256; } else { s0 = NCTX + ((n - NCTX) & ~4095); s1 = s0 + 4096; }
  const float* cw = P.conv + (size_t)l * 5 * 1536;
#pragma unroll
  for (int i = 0; i < 6; i++) {
    const int c = tid + 256 * i;
    float a = 0.f;
#pragma unroll
    for (int j = 0; j < 5; j++) {
      const int nn = n + j - 2;
      if (nn >= s0 && nn < s1) a += cw[j * 1536 + c] * bf2f(P.qkv_raw[(size_t)nn * 1536 + c]);
    }
    float y = siluf_(a);
    if (i < 4) {
      const float ss = wave_sum(y * y);
      y *= rsqrtf(ss + EPS);
      if (i < 2) y *= 0.125f;
    }
    if (i < 2) P.fq[(size_t)n * 512 + c] = f2bf(y);
    else if (i < 4) P.fk[(size_t)n * 512 + c - 512] = f2bf(y);
    else P.fv[(size_t)n * 512 + c - 1024] = f2bf(y);
  }
  if (tid < 16) {
    P.bg[(size_t)n * 32 + tid] = sigmoidf_(P.ba[(size_t)n * 32 + tid]);
  } else if (tid < 32) {
    const int idx = tid - 16;
    const float x = P.ba[(size_t)n * 32 + 16 + idx] + P.dt_bias[l * 16 + idx];
    const float sp = x > 20.f ? x : log1pf(expf(x));
    P.bg[(size_t)n * 32 + 16 + idx] = -expf(P.a_log[l * 16 + idx]) * sp;
  }
}

DI void attn_item(const bf16_t* __restrict__ Q, const bf16_t* __restrict__ Kp, const bf16_t* __restrict__ Vt, int vstride, int nA, int tb0, int tb1,
                  int qpos0, bool has_sink, float sinkv, bf16_t* __restrict__ Y, bf16_t* sm) {
  const int tid = threadIdx.x, lane = tid & 63, wid = tid >> 6, lr = lane & 15, quad = lane >> 4;
  bf16_t* sK = sm;
  bf16_t* sV = sm + 64 * 72;
  bf16x8 bq[2][2];
#pragma unroll
  for (int qt = 0; qt < 2; qt++)
#pragma unroll
    for (int ks = 0; ks < 2; ks++) bq[qt][ks] = *(const bf16x8*)(Q + (size_t)(wid * 32 + qt * 16 + lr) * 512 + ks * 32 + quad * 8);
  f32x4 O[4][2];
#pragma unroll
  for (int dt = 0; dt < 4; dt++) { O[dt][0] = (f32x4){0.f, 0.f, 0.f, 0.f}; O[dt][1] = (f32x4){0.f, 0.f, 0.f, 0.f}; }
  float mrun[2], lsum[2];
  mrun[0] = mrun[1] = has_sink ? sinkv : -1e30f;
  lsum[0] = lsum[1] = 0.f;
  const int ntiles = nA + (tb1 - tb0);
  for (int it = 0; it < ntiles; it++) {
    const bool masked = it >= nA;
    const int tile = masked ? tb0 + (it - nA) : it;
    const int p0 = tile * 64;
    __syncthreads();
#pragma unroll
    for (int i = 0; i < 2; i++) {
      const int ch = tid + 256 * i, r = ch >> 3, cc = (ch & 7) * 8;
      *(uint4*)(sK + r * 72 + cc) = *(const uint4*)(Kp + (size_t)(p0 + r) * 64 + cc);
      *(uint4*)(sV + r * 72 + cc) = *(const uint4*)(Vt + (size_t)r * vstride + p0 + cc);
    }
    __syncthreads();
    f32x4 s[4][2];
#pragma unroll
    for (int kt = 0; kt < 4; kt++) {
      const bf16x8 a0 = *(const bf16x8*)(sK + (kt * 16 + lr) * 72 + quad * 8);
      const bf16x8 a1 = *(const bf16x8*)(sK + (kt * 16 + lr) * 72 + 32 + quad * 8);
#pragma unroll
      for (int qt = 0; qt < 2; qt++) {
        f32x4 t = MFMA16(a0, bq[qt][0], ((f32x4){0.f, 0.f, 0.f, 0.f}));
        s[kt][qt] = MFMA16(a1, bq[qt][1], t);
      }
    }
    if (masked) {
#pragma unroll
      for (int kt = 0; kt < 4; kt++)
#pragma unroll
        for (int qt = 0; qt < 2; qt++)
#pragma unroll
          for (int j = 0; j < 4; j++) {
            const int key = p0 + kt * 16 + quad * 4 + j;
            const int qp = qpos0 + wid * 32 + qt * 16 + lr;
            const int d = key - qp;
            if (d > 128 || d < -128) s[kt][qt][j] = -1e30f;
          }
    }
#pragma unroll
    for (int qt = 0; qt < 2; qt++) {
      float mx = -1e30f;
#pragma unroll
      for (int kt = 0; kt < 4; kt++)
#pragma unroll
        for (int j = 0; j < 4; j++) mx = fmaxf(mx, s[kt][qt][j]);
      mx = fmaxf(mx, __shfl_xor(mx, 16));
      mx = fmaxf(mx, __shfl_xor(mx, 32));
      const float mnew = fmaxf(mrun[qt], mx);
      const float alpha = __expf(mrun[qt] - mnew);
      mrun[qt] = mnew;
      float rs = 0.f;
#pragma unroll
      for (int kt = 0; kt < 4; kt++)
#pragma unroll
        for (int j = 0; j < 4; j++) { const float p = __expf(s[kt][qt][j] - mnew); s[kt][qt][j] = p; rs += p; }
      lsum[qt] = lsum[qt] * alpha + rs;
#pragma unroll
      for (int dt = 0; dt < 4; dt++) O[dt][qt] *= alpha;
    }
#pragma unroll
    for (int kk = 0; kk < 2; kk++) {
      bf16x8 bp[2];
#pragma unroll
      for (int qt = 0; qt < 2; qt++) {
        union { bf16x8 v; unsigned u[4]; } pk;
        pk.u[0] = pack2(s[2 * kk][qt][0], s[2 * kk][qt][1]);
        pk.u[1] = pack2(s[2 * kk][qt][2], s[2 * kk][qt][3]);
        pk.u[2] = pack2(s[2 * kk + 1][qt][0], s[2 * kk + 1][qt][1]);
        pk.u[3] = pack2(s[2 * kk + 1][qt][2], s[2 * kk + 1][qt][3]);
        bp[qt] = pk.v;
      }
#pragma unroll
      for (int dt = 0; dt < 4; dt++) {
        const bf16_t* vp = sV + (dt * 16 + lr) * 72 + kk * 32 + quad * 4;
        const bf16x4 v0 = *(const bf16x4*)vp;
        const bf16x4 v1 = *(const bf16x4*)(vp + 16);
        const bf16x8 av = __builtin_shufflevector(v0, v1, 0, 1, 2, 3, 4, 5, 6, 7);
#pragma unroll
        for (int qt = 0; qt < 2; qt++) O[dt][qt] = MFMA16(av, bp[qt], O[dt][qt]);
      }
    }
  }
#pragma unroll
  for (int qt = 0; qt < 2; qt++) {
    float lt = lsum[qt];
    lt += __shfl_xor(lt, 16);
    lt += __shfl_xor(lt, 32);
    if (has_sink) lt += __expf(sinkv - mrun[qt]);
    const float inv = 1.f / lt;
    bf16_t* yr = Y + (size_t)(wid * 32 + qt * 16 + lr) * 512;
#pragma unroll
    for (int dt = 0; dt < 4; dt++) {
      uint2 o;
      o.x = pack2(O[dt][qt][0] * inv, O[dt][qt][1] * inv);
      o.y = pack2(O[dt][qt][2] * inv, O[dt][qt][3] * inv);
      *(uint2*)(yr + dt * 16 + quad * 4) = o;
    }
  }
}

DI void gdn_rec_item(const Params& P, int l, int seq, int h, int dir, float* sm) {
  const int tid = threadIdx.x, lane = tid & 63, wid = tid >> 6, lr = lane & 15, db = lane >> 4;
  const int e = wid * 16 + lr;
  const bool ctx = seq < 16;
  const int T = ctx ? 256 : 4096;
  const int n0 = ctx ? seq * 256 : NCTX + (seq - 16) * 4096;
  float S[16];
  if (ctx) {
#pragma unroll
    for (int i = 0; i < 16; i++) S[i] = 0.f;
  } else {
    const float* src = P.state + ((((size_t)(seq - 16) * 4 + l) * 2 + dir) * 8 + h) * 4096;
#pragma unroll
    for (int i = 0; i < 16; i++) S[i] = src[(db * 16 + i) * 64 + e];
  }
  float* sq = sm; float* sk = sm + 4096; float* sv = sm + 8192; float* sb = sm + 12288; float* sg = sm + 12352;
  float* obuf = dir ? P.ob : P.of;
  for (int c = 0; c < T / 64; c++) {
    __syncthreads();
    {
      const int r = tid >> 2, part = (tid & 3) * 16;
      const int tt = c * 64 + r;
      const int t = dir ? T - 1 - tt : tt;
      const size_t n = (size_t)n0 + t;
      const size_t off = n * 512 + h * 64 + part;
      union { uint4 u[2]; bf16_t b[16]; } bq_, bk_, bv_;
      bq_.u[0] = *(const uint4*)(P.fq + off); bq_.u[1] = *(const uint4*)(P.fq + off + 8);
      bk_.u[0] = *(const uint4*)(P.fk + off); bk_.u[1] = *(const uint4*)(P.fk + off + 8);
      bv_.u[0] = *(const uint4*)(P.fv + off); bv_.u[1] = *(const uint4*)(P.fv + off + 8);
#pragma unroll
      for (int i = 0; i < 16; i++) { sq[r * 64 + part + i] = bf2f(bq_.b[i]); sk[r * 64 + part + i] = bf2f(bk_.b[i]); sv[r * 64 + part + i] = bf2f(bv_.b[i]); }
      if ((tid & 3) == 0) { sb[r] = P.bg[n * 32 + dir * 8 + h]; sg[r] = __expf(P.bg[n * 32 + 16 + dir * 8 + h]); }
    }
    __syncthreads();
    for (int r = 0; r < 64; r++) {
      float kd[16], qd[16];
#pragma unroll
      for (int i4 = 0; i4 < 4; i4++) {
        const float4 k4 = *(const float4*)(sk + r * 64 + db * 16 + i4 * 4);
        const float4 q4 = *(const float4*)(sq + r * 64 + db * 16 + i4 * 4);
        kd[i4 * 4 + 0] = k4.x; kd[i4 * 4 + 1] = k4.y; kd[i4 * 4 + 2] = k4.z; kd[i4 * 4 + 3] = k4.w;
        qd[i4 * 4 + 0] = q4.x; qd[i4 * 4 + 1] = q4.y; qd[i4 * 4 + 2] = q4.z; qd[i4 * 4 + 3] = q4.w;
      }
      float part = 0.f;
#pragma unroll
      for (int i = 0; i < 16; i++) part += kd[i] * S[i];
      part += __shfl_xor(part, 16);
      part += __shfl_xor(part, 32);
      const float eg = sg[r], bt = sb[r];
      const float coef = bt * (sv[r * 64 + e] - eg * part);
      float op = 0.f;
#pragma unroll
      for (int i = 0; i < 16; i++) { S[i] = eg * S[i] + kd[i] * coef; op += qd[i] * S[i]; }
      op += __shfl_xor(op, 16);
      op += __shfl_xor(op, 32);
      if (db == 0) {
        const int tt = c * 64 + r;
        const int t = dir ? T - 1 - tt : tt;
        obuf[((size_t)n0 + t) * 512 + h * 64 + e] = op;
      }
    }
  }
  if (ctx) {
    float* dst = P.out + OUT_ST + ((((size_t)seq * 4 + l) * 2 + dir) * 8 + h) * 4096;
#pragma unroll
    for (int i = 0; i < 16; i++) dst[(db * 16 + i) * 64 + e] = S[i];
  }
}

constexpr int MIX_GL = 32, MIX_BL = 512, MIX_CL = 512, MIX_GC = 256, MIX_BC = 256, MIX_CC = 256;
constexpr int MIX_N = MIX_GL + MIX_BL + MIX_CL + MIX_GC + MIX_BC + MIX_CC;

DI void mix_item(const Params& P, int l, int item, char* smem) {
  if (item < MIX_GL) { gdn_rec_item(P, l, 16 + (item >> 4), (item >> 1) & 7, item & 1, (float*)smem); return; }
  item -= MIX_GL;
  if (item < MIX_BL + MIX_CL) {
    const int typeC = item >= MIX_BL;
    const int i = typeC ? item - MIX_BL : item;
    const int b = i >> 8, head = (i >> 5) & 7, qb = i & 31, kvh = head >> 2;
    const size_t tok0 = (size_t)NCTX + b * 4096 + qb * 128;
    const bf16_t* Q = (typeC ? P.qC : P.qB) + tok0 * 512 + head * 64;
    const bf16_t* Kp = (typeC ? P.kfC : P.kfB) + (size_t)(b * 2 + kvh) * LFULL * 64;
    const bf16_t* Vt = (typeC ? P.vtfC : P.vtfB) + (size_t)(b * 2 + kvh) * 64 * LFULL;
    bf16_t* Y = (typeC ? P.yc : P.yb) + tok0 * 512 + head * 64;
    if (!typeC) {
      attn_item(Q, Kp, Vt, LFULL, 72, 0, 0, 0, false, 0.f, Y, (bf16_t*)smem);
    } else {
      const int start = qb * 128;
      const int lo = start - 128 < 0 ? 0 : start - 128;
      const int hi = start + 256 > 4096 ? 4096 : start + 256;
      attn_item(Q, Kp, Vt, LFULL, 8, (512 + lo) >> 6, (512 + hi) >> 6, 512 + start, true, P.sink[l * 8 + head], Y, (bf16_t*)smem);
    }
    return;
  }
  item -= MIX_BL + MIX_CL;
  if (item < MIX_GC) { gdn_rec_item(P, l, item >> 4, (item >> 1) & 7, item & 1, (float*)smem); return; }
  item -= MIX_GC;
  {
    const int typeC = item >= MIX_BC;
    const int i = typeC ? item - MIX_BC : item;
    const int b = i >> 4, head = (i >> 1) & 7, qb = i & 1, kvh = head >> 2;
    const size_t tok0 = (size_t)b * 256 + qb * 128;
    const bf16_t* Q = (typeC ? P.qC : P.qB) + tok0 * 512 + head * 64;
    const bf16_t* Kp = (typeC ? P.kcC : P.kcB) + (size_t)(b * 2 + kvh) * 256 * 64;
    const bf16_t* Vt = (typeC ? P.vtcC : P.vtcB) + (size_t)(b * 2 + kvh) * 64 * 256;
    bf16_t* Y = (typeC ? P.yc : P.yb) + tok0 * 512 + head * 64;
    attn_item(Q, Kp, Vt, 256, 4, 0, 0, 0, typeC != 0, typeC ? P.sink[l * 8 + head] : 0.f, Y, (bf16_t*)smem);
  }
}

DI void gdnout_item(const Params& P, int l, int n) {
  const int tid = threadIdx.x, lane = tid & 63, wid = tid >> 6;
#pragma unroll
  for (int k = 0; k < 2; k++) {
    const int hh = wid * 2 + k;
    const size_t idx = (size_t)n * 512 + hh * 64 + lane;
    const float o = P.of[idx] + P.ob[idx];
    const float ss = wave_sum(o * o);
    const float on = o * rsqrtf(ss * (1.f / 64.f) + EPS) * P.a_norm[l * 64 + lane];
    const float zz = bf2f(P.z[idx]);
    P.ya[idx] = f2bf(on * siluf_(zz));
  }
}

enum { PH_PREP = 0, PH_NORM1, PH_GEMM_IN, PH_FEAT, PH_MIX, PH_GDNOUT, PH_GEMM_BR, PH_GEMM_O, PH_NORM2, PH_FF1, PH_FF2, PH_COUNT };

__host__ __device__ inline int phase_count(int ph) {
  switch (ph) {
    case PH_PREP: return PREP_N;
    case PH_NORM1: return NORM1_N;
    case PH_GEMM_IN: return GEMM_IN_N;
    case PH_FEAT: return NTOK;
    case PH_MIX: return MIX_N;
    case PH_GDNOUT: return NTOK;
    case PH_GEMM_BR: return GEMM_BR_N;
    case PH_GEMM_O: return GEMM_D_N;
    case PH_NORM2: return NORM_ROWS;
    case PH_FF1: return GEMM_FF1_N;
    case PH_FF2: return GEMM_D_N;
  }
  return 0;
}

DI void run_item(const Params& P, int ph, int l, int item, char* smem) {
  switch (ph) {
    case PH_PREP: prep_item(P, item, smem); break;
    case PH_NORM1: if (item < NORM_ROWS) modnorm_item(P, l, 0, item); else cache_item(P, l, item - NORM_ROWS); break;
    case PH_GEMM_IN: gemm_in_item(P, l, item, smem); break;
    case PH_FEAT: feat_item(P, l, item); break;
    case PH_MIX: mix_item(P, l, item, smem); break;
    case PH_GDNOUT: gdnout_item(P, l, item); break;
    case PH_GEMM_BR: gemm_br_item(P, l, item, smem); break;
    case PH_GEMM_O: gemm_res_item(P, l, item, smem, P.h, 1024, P.wt_o + (size_t)l * 1024 * 1024, 2048); break;
    case PH_NORM2: modnorm_item(P, l, 1, item); break;
    case PH_FF1: gemm_ff1_item(P, l, item, smem); break;
    case PH_FF2: gemm_res_item(P, l, item, smem, P.f, 4096, P.wt_ff2 + (size_t)l * 1024 * 4096, 5120); break;
  }
}

#if !MEGA
template <int PH>
__global__ void __launch_bounds__(256, 2) k_phase(Params P, int l) {
  __shared__ __attribute__((aligned(16))) char smem[SMEM_BYTES];
  const int n = phase_count(PH);
  for (int item = blockIdx.x; item < n; item += gridDim.x) run_item(P, PH, l, item, smem);
}
#else
__global__ void __launch_bounds__(256, 2) k_mega(Params P) {
  __shared__ __attribute__((aligned(16))) char smem[SMEM_BYTES];
  __shared__ int s_item;
  cg::grid_group grid = cg::this_grid();
  for (int item = blockIdx.x; item < PREP_N; item += gridDim.x) run_item(P, PH_PREP, 0, item, smem);
  grid.sync();
  for (int l = 0; l < 4; l++) {
    for (int ph = PH_NORM1; ph < PH_COUNT; ph++) {
      const int n = phase_count(ph);
      if (ph == PH_MIX) {
        for (;;) {
          __syncthreads();
          if (threadIdx.x == 0) s_item = (int)atomicAdd(P.counters + l, 1u);
          __syncthreads();
          const int item = s_item;
          if (item >= n) break;
          run_item(P, ph, l, item, smem);
        }
      } else {
        for (int item = blockIdx.x; item < n; item += gridDim.x) run_item(P, ph, l, item, smem);
      }
      grid.sync();
    }
  }
}
#endif

static inline size_t align_up(size_t x) { return (x + 255) & ~(size_t)255; }

extern "C" void kernel_launch(void* const* d_in, const int* in_sizes, int n_in, void* d_out, int out_size, void* d_ws, size_t ws_size, hipStream_t stream) {
  Params P;
  memset(&P, 0, sizeof(P));
  P.x_prompt = (const float*)d_in[0]; P.x_sample = (const float*)d_in[1];
  P.ckg = (const float*)d_in[2]; P.cvg = (const float*)d_in[3]; P.ckw = (const float*)d_in[4]; P.cvw = (const float*)d_in[5];
  P.state = (const float*)d_in[6]; P.c = (const float*)d_in[7]; P.c_ctx = (const float*)d_in[8];
  P.w_mod = (const float*)d_in[9]; P.b_mod = (const float*)d_in[10]; P.ln1 = (const float*)d_in[11]; P.ln2 = (const float*)d_in[12];
  P.w_in = (const float*)d_in[13]; P.conv = (const float*)d_in[14]; P.a_log = (const float*)d_in[15]; P.dt_bias = (const float*)d_in[16];
  P.a_norm = (const float*)d_in[17]; P.qk_norm = (const float*)d_in[18]; P.sink = (const float*)d_in[19];
  P.w_br_a = (const float*)d_in[20]; P.w_br_b = (const float*)d_in[21]; P.w_br_c = (const float*)d_in[22];
  P.w_o = (const float*)d_in[23]; P.w_ff1 = (const float*)d_in[24]; P.w_ff2 = (const float*)d_in[25];
  P.out = (float*)d_out;
  char* ws = (char*)d_ws;
  size_t off = 0;
  auto take = [&](size_t bytes) { char* p = ws + off; off = align_up(off + bytes); return p; };
  P.wt_in = (bf16_t*)take((size_t)4 * NCOLP * 1024 * 2);
  P.wt_br = (bf16_t*)take((size_t)4 * 3 * 1024 * 512 * 2);
  P.wt_o = (bf16_t*)take((size_t)4 * 1024 * 1024 * 2);
  P.wt_ff1 = (bf16_t*)take((size_t)4 * 4096 * 1024 * 2);
  P.wt_ff2 = (bf16_t*)take((size_t)4 * 4096 * 1024 * 2);
  P.mods = (float*)take((size_t)4 * 3 * 6144 * 4);
  P.ropec = (float*)take((size_t)4096 * 32 * 4);
  P.ropes = (float*)take((size_t)4096 * 32 * 4);
  P.counters = (unsigned*)take(1024);
  P.h = (bf16_t*)take((size_t)NTOK * DM * 2);
  P.kfB = (bf16_t*)take((size_t)4 * LFULL * 64 * 2);
  P.vtfB = (bf16_t*)take((size_t)4 * LFULL * 64 * 2);
  P.kfC = (bf16_t*)take((size_t)4 * LFULL * 64 * 2);
  P.vtfC = (bf16_t*)take((size_t)4 * LFULL * 64 * 2);
  P.kcB = (bf16_t*)take((size_t)32 * 256 * 64 * 2);
  P.vtcB = (bf16_t*)take((size_t)32 * 256 * 64 * 2);
  P.kcC = (bf16_t*)take((size_t)32 * 256 * 64 * 2);
  P.vtcC = (bf16_t*)take((size_t)32 * 256 * 64 * 2);
  P.ba = (float*)take((size_t)NTOK * 32 * 4);
  P.bg = (float*)take((size_t)NTOK * 32 * 4);
  P.yb = (bf16_t*)take((size_t)NTOK * 512 * 2);
  P.yc = (bf16_t*)take((size_t)NTOK * 512 * 2);
  P.qC = (bf16_t*)take((size_t)NTOK * 512 * 2);
  char* fregion = take((size_t)NTOK * DFF * 2);
  P.f = (bf16_t*)fregion;
  P.gates = (bf16_t*)fregion;
  P.z = (bf16_t*)(fregion + (size_t)NTOK * 3072 * 2);
  P.qB = (bf16_t*)(fregion + (size_t)NTOK * 3072 * 2 + (size_t)NTOK * 512 * 2);
  P.fq = (bf16_t*)take((size_t)NTOK * 512 * 2);
  P.fk = (bf16_t*)take((size_t)NTOK * 512 * 2);
  P.fv = (bf16_t*)take((size_t)NTOK * 512 * 2);
  P.ya = P.fq;
  char* oregion = take((size_t)NTOK * 512 * 4 * 2);
  P.of = (float*)oregion;
  P.ob = (float*)(oregion + (size_t)NTOK * 512 * 4);
  P.qkv_raw = (bf16_t*)oregion;
  if (off > ws_size) { fprintf(stderr, "workspace too small: need %zu have %zu\n", off, ws_size); return; }

#if !MEGA
#define LAUNCH(PH, l) hipLaunchKernelGGL(k_phase<PH>, dim3(phase_count(PH) < 8192 ? phase_count(PH) : 8192), dim3(256), 0, stream, P, l)
  LAUNCH(PH_PREP, 0);
  for (int l = 0; l < 4; l++) {
    LAUNCH(PH_NORM1, l); LAUNCH(PH_GEMM_IN, l); LAUNCH(PH_FEAT, l); LAUNCH(PH_MIX, l); LAUNCH(PH_GDNOUT, l);
    LAUNCH(PH_GEMM_BR, l); LAUNCH(PH_GEMM_O, l); LAUNCH(PH_NORM2, l); LAUNCH(PH_FF1, l); LAUNCH(PH_FF2, l);
  }
#else
  static int grid_blocks = 0;
  if (!grid_blocks) {
    int dev = 0, cus = 0, per_cu = 0;
    hipGetDevice(&dev);
    hipDeviceGetAttribute(&cus, hipDeviceAttributeMultiprocessorCount, dev);
    hipOccupancyMaxActiveBlocksPerMultiprocessor(&per_cu, k_mega, 256, 0);
    if (per_cu > 2) per_cu = 2;
    grid_blocks = cus * per_cu;
  }
  void* args[] = {&P};
  hipError_t e = hipLaunchCooperativeKernel((void*)k_mega, dim3(grid_blocks), dim3(256), args, 0, stream);
  if (e != hipSuccess) fprintf(stderr, "cooperative launch failed: %s (grid %d)\n", hipGetErrorString(e), grid_blocks);
#endif
}
```

```cpp
#include <hip/hip_runtime.h>
#include <hip/hip_cooperative_groups.h>
#include <stdint.h>
#include <stdio.h>
#include <string.h>
namespace cg = cooperative_groups;

#ifndef MEGA
#define MEGA 1
#endif

typedef unsigned short bf16_t;
typedef __attribute__((ext_vector_type(8))) short bf16x8;
typedef __attribute__((ext_vector_type(4))) short bf16x4;
typedef __attribute__((ext_vector_type(4))) float f32x4;
#define DI __device__ __forceinline__
#define MFMA16(a, b, c) __builtin_amdgcn_mfma_f32_16x16x32_bf16((a), (b), (c), 0, 0, 0)

constexpr int NTOK = 12288, NCTX = 4096, DM = 1024, NCOLP = 6784, INCOLS = 6688, DFF = 4096;
constexpr int LFULL = 4608;
constexpr float EPS = 1e-6f;
constexpr float LOG2E = 1.4426950408889634f;
constexpr float QSCALE = 0.125f * LOG2E;
constexpr size_t OUT_KG = 12582912, OUT_VG = 14680064, OUT_KW = 16777216, OUT_VW = 18874368, OUT_ST = 20971520;
constexpr int SMEM_BYTES = 73728;

struct Params {
  const float *x_prompt, *x_sample, *ckg, *cvg, *ckw, *cvw, *state, *c, *c_ctx, *w_mod, *b_mod, *ln1, *ln2, *w_in, *conv,
      *a_log, *dt_bias, *a_norm, *qk_norm, *sink, *w_br_a, *w_br_b, *w_br_c, *w_o, *w_ff1, *w_ff2;
  float* out;
  bf16_t *wt_in, *wt_br, *wt_o, *wt_ff1, *wt_ff2;
  float *mods, *ropec, *ropes;
  unsigned* counters;
  unsigned* bar;
  long long never;
  bf16_t* h;
  bf16_t *qkv_raw, *z, *qB, *qC, *gates;
  float *ba, *bg;
  bf16_t *gq, *gkT, *gw, *gu, *gattn, *obf;
  float *geg, *gks, *ggl;
  bf16_t *kfB, *vtfB, *kfC, *vtfC;
  bf16_t *kcB, *vtcB, *kcC, *vtcC;
  bf16_t *ya, *yb, *yc;
  bf16_t* f;
};

typedef const __attribute__((address_space(4))) Params* CP;

DI CP launder_params() {
  CP cp = (CP)__builtin_amdgcn_kernarg_segment_ptr();
  asm volatile("" : "+s"(cp));
  return cp;
}

DI float bf2f(bf16_t x) { return __uint_as_float(((unsigned)x) << 16); }
DI unsigned pack2(float a, float b) { unsigned r; asm("v_cvt_pk_bf16_f32 %0, %1, %2" : "=v"(r) : "v"(a), "v"(b)); return r; }
DI bf16_t f2bf(float f) { unsigned u = __float_as_uint(f); u += 0x7fffu + ((u >> 16) & 1u); return (bf16_t)(u >> 16); }
typedef __attribute__((ext_vector_type(4))) unsigned u32x4_t;
DI bf16x8 pack8(float x0, float x1, float x2, float x3, float x4, float x5, float x6, float x7) {
  u32x4_t p;
  asm volatile("v_cvt_pk_bf16_f32 %0, %4, %5\n\tv_cvt_pk_bf16_f32 %1, %6, %7\n\tv_cvt_pk_bf16_f32 %2, %8, %9\n\tv_cvt_pk_bf16_f32 %3, %10, %11\n\ts_nop 1"
               : "=&v"(p[0]), "=&v"(p[1]), "=&v"(p[2]), "=&v"(p[3])
               : "v"(x0), "v"(x1), "v"(x2), "v"(x3), "v"(x4), "v"(x5), "v"(x6), "v"(x7));
  return __builtin_bit_cast(bf16x8, p);
}
DI int tidx() { int t = threadIdx.x; asm volatile("" : "+v"(t)); return t; }
DI float wave_sum(float v) {
#pragma unroll
  for (int o = 32; o > 0; o >>= 1) v += __shfl_xor(v, o);
  return v;
}
DI float sigmoidf_(float x) { return 1.f / (1.f + __expf(-x)); }
DI float siluf_(float x) { return x / (1.f + __expf(-x)); }
DI int mod_index(int n) { return n < NCTX ? 0 : 1 + ((n - NCTX) >> 12); }

constexpr int PREP_MODS = 384, PREP_TRL = 4384, PREP_TR = 4 * PREP_TRL, PREP_XC = 768, PREP_ROPE = 32, PREP_MISC = 1;
constexpr int PREP_N = PREP_MODS + PREP_TR + PREP_XC + PREP_ROPE + PREP_MISC;

DI void tr_tile(const float* __restrict__ src, int ldsrc, int srccol0, int nvalid, bf16_t* __restrict__ dst, int ldd, int n0, int k0, float* tile) {
  const int tid = tidx();
  {
    const int nn4 = (tid & 15) * 4;
#pragma unroll
    for (int i = 0; i < 4; i++) {
      const int kk = (tid >> 4) + 16 * i;
      float4 v = make_float4(0.f, 0.f, 0.f, 0.f);
      if (nn4 < nvalid) v = *(const float4*)(src + (size_t)(k0 + kk) * ldsrc + srccol0 + nn4);
      tile[kk * 65 + nn4 + 0] = v.x; tile[kk * 65 + nn4 + 1] = v.y; tile[kk * 65 + nn4 + 2] = v.z; tile[kk * 65 + nn4 + 3] = v.w;
    }
  }
  __syncthreads();
  {
    const int kk4 = (tid & 15) * 4;
#pragma unroll
    for (int i = 0; i < 4; i++) {
      const int nn = (tid >> 4) + 16 * i;
      uint2 o;
      o.x = pack2(tile[(kk4 + 0) * 65 + nn], tile[(kk4 + 1) * 65 + nn]);
      o.y = pack2(tile[(kk4 + 2) * 65 + nn], tile[(kk4 + 3) * 65 + nn]);
      *(uint2*)(dst + (size_t)(n0 + nn) * ldd + k0 + kk4) = o;
    }
  }
  __syncthreads();
}

DI void prep_item(CP P, int item, char* smem) {
  const int tid = tidx(), lane = tid & 63, wid = tid >> 6;
  float* sm = (float*)smem;
  if (item < PREP_MODS) {
    const int l = item / 96, jb = item % 96;
    float* ssil = sm;
    float* red = sm + 3072;
    for (int k = tid; k < 1024; k += 256) {
      ssil[k] = siluf_(P->c_ctx[k]);
      ssil[1024 + k] = siluf_(P->c[k]);
      ssil[2048 + k] = siluf_(P->c[1024 + k]);
    }
    __syncthreads();
    const float* W = P->w_mod + (size_t)l * 1024 * 6144 + jb * 64 + lane;
    float a0 = 0.f, a1 = 0.f, a2 = 0.f;
    const int kb = wid * 256;
#pragma unroll 8
    for (int k = 0; k < 256; k++) {
      const float w = W[(size_t)(kb + k) * 6144];
      a0 += ssil[kb + k] * w; a1 += ssil[1024 + kb + k] * w; a2 += ssil[2048 + kb + k] * w;
    }
    red[(wid * 3 + 0) * 64 + lane] = a0; red[(wid * 3 + 1) * 64 + lane] = a1; red[(wid * 3 + 2) * 64 + lane] = a2;
    __syncthreads();
    if (tid < 192) {
      const int m = tid >> 6, jj = tid & 63;
      float s = 0.f;
      for (int w = 0; w < 4; w++) s += red[(w * 3 + m) * 64 + jj];
      P->mods[((size_t)l * 3 + m) * 6144 + jb * 64 + jj] = s + P->b_mod[(size_t)l * 6144 + jb * 64 + jj];
    }
    __syncthreads();
    return;
  }
  item -= PREP_MODS;
  if (item < PREP_TR) {
    const int l = item / PREP_TRL; int s = item % PREP_TRL;
    if (s < 1696) {
      const int nt = s / 16, kt = s % 16;
      int srccol0 = nt * 64, nvalid = 64;
      if (nt == 32) { srccol0 = 2048; nvalid = 32; } else if (nt > 32 && nt < 105) { srccol0 = nt * 64 - 32; } else if (nt >= 105) { nvalid = 0; srccol0 = 0; }
      tr_tile(P->w_in + (size_t)l * 1024 * INCOLS, INCOLS, srccol0, nvalid, P->wt_in + (size_t)l * NCOLP * 1024, 1024, nt * 64, kt * 64, sm);
      return;
    }
    s -= 1696;
    if (s < 384) {
      const int which = s / 128, r = s % 128, nt = r / 8, kt = r % 8;
      const float* src = (which == 0 ? P->w_br_a : which == 1 ? P->w_br_b : P->w_br_c) + (size_t)l * 512 * 1024;
      tr_tile(src, 1024, nt * 64, 64, P->wt_br + (size_t)(l * 3 + which) * 1024 * 512, 512, nt * 64, kt * 64, sm);
      return;
    }
    s -= 384;
    if (s < 256) {
      const int nt = s / 16, kt = s % 16;
      tr_tile(P->w_o + (size_t)l * 1024 * 1024, 1024, nt * 64, 64, P->wt_o + (size_t)l * 1024 * 1024, 1024, nt * 64, kt * 64, sm);
      return;
    }
    s -= 256;
    if (s < 1024) {
      const int nt = s / 16, kt = s % 16;
      tr_tile(P->w_ff1 + (size_t)l * 1024 * 4096, 4096, nt * 64, 64, P->wt_ff1 + (size_t)l * 4096 * 1024, 1024, nt * 64, kt * 64, sm);
      return;
    }
    s -= 1024;
    {
      const int nt = s / 64, kt = s % 64;
      tr_tile(P->w_ff2 + (size_t)l * 4096 * 1024, 1024, nt * 64, 64, P->wt_ff2 + (size_t)l * 1024 * 4096, 4096, nt * 64, kt * 64, sm);
      return;
    }
  }
  item -= PREP_TR;
  if (item < PREP_XC) {
    const size_t base = (size_t)item * 16384;
    const float4* src = (const float4*)(base < 4194304 ? P->x_prompt + base : P->x_sample + (base - 4194304));
    float4* dst = (float4*)(P->out + base);
#pragma unroll 4
    for (int i = 0; i < 16; i++) dst[tid + 256 * i] = src[tid + 256 * i];
    return;
  }
  item -= PREP_XC;
  if (item < PREP_ROPE) {
    for (int i = 0; i < 16; i++) {
      const int e = item * 4096 + tid + 256 * i;
      const int t = e >> 5, i2 = e & 31;
      const int pos = (i2 < 16) ? (t >> 6) : (t & 63);
      const int fi = i2 & 15;
      const float inv = exp2f(-(float)fi * (13.287712379549449f / 16.f));
      const float ang = (float)pos * inv;
      P->ropec[e] = cosf(ang);
      P->ropes[e] = sinf(ang);
    }
    return;
  }
  item -= PREP_ROPE;
  if (tid < 64) P->counters[tid] = 0u;
}

constexpr int NORM_ROWS = NTOK / 8;
constexpr int NORM1_N = NORM_ROWS + 512;

DI void modnorm_item(CP P, int l, int which, int item) {
  const int tid = tidx(), lane = tid & 63, wid = tid >> 6;
  const int nb = item * 8 + wid * 2;
  float4 v[2][4];
  float ss[2];
#pragma unroll
  for (int r = 0; r < 2; r++) {
    const float* xr = P->out + (size_t)(nb + r) * DM;
#pragma unroll
    for (int i = 0; i < 4; i++) v[r][i] = *(const float4*)(xr + lane * 4 + 256 * i);
  }
  const float* md = P->mods + ((size_t)l * 3 + mod_index(nb)) * 6144;
  const float* sh = md + (which ? 3072 : 0);
  const float* sc = md + (which ? 4096 : 1024);
  const float* lw = (which ? P->ln2 : P->ln1) + (size_t)l * DM;
  float4 w4[4], s4[4], h4[4];
#pragma unroll
  for (int i = 0; i < 4; i++) {
    const int c = lane * 4 + 256 * i;
    w4[i] = *(const float4*)(lw + c); s4[i] = *(const float4*)(sc + c); h4[i] = *(const float4*)(sh + c);
    w4[i].x *= 1.f + s4[i].x; w4[i].y *= 1.f + s4[i].y; w4[i].z *= 1.f + s4[i].z; w4[i].w *= 1.f + s4[i].w;
  }
#pragma unroll
  for (int r = 0; r < 2; r++) {
    float a = 0.f;
#pragma unroll
    for (int i = 0; i < 4; i++) a += v[r][i].x * v[r][i].x + v[r][i].y * v[r][i].y + v[r][i].z * v[r][i].z + v[r][i].w * v[r][i].w;
    ss[r] = wave_sum(a);
  }
#pragma unroll
  for (int r = 0; r < 2; r++) {
    const float rstd = rsqrtf(ss[r] * (1.f / 1024.f) + EPS);
#pragma unroll
    for (int i = 0; i < 4; i++) {
      const int c = lane * 4 + 256 * i;
      uint2 o;
      o.x = pack2(v[r][i].x * rstd * w4[i].x + h4[i].x, v[r][i].y * rstd * w4[i].y + h4[i].y);
      o.y = pack2(v[r][i].z * rstd * w4[i].z + h4[i].z, v[r][i].w * rstd * w4[i].w + h4[i].w);
      *(uint2*)(P->h + (size_t)(nb + r) * DM + c) = o;
    }
  }
}

DI void cache_item(CP P, int l, int item) {
  const int tid = tidx();
  const int type = item >> 8, b = (item >> 7) & 1, pg = item & 127;
  const float* ck = type ? P->ckw : P->ckg;
  const float* cv = type ? P->cvw : P->cvg;
  bf16_t* kf = type ? P->kfC : P->kfB;
  bf16_t* vtf = type ? P->vtfC : P->vtfB;
#pragma unroll
  for (int i = 0; i < 2; i++) {
    const int e = tid + 256 * i;
    const int pl = e >> 7, c = e & 127, kvh = c >> 6, d = c & 63;
    const int pos = pg * 4 + pl;
    const size_t si = ((((size_t)b * 4 + l) * 512 + pos) * 2 + kvh) * 64 + d;
    kf[((size_t)(b * 2 + kvh) * LFULL + pos) * 64 + d] = f2bf(ck[si]);
    vtf[((size_t)(b * 2 + kvh) * 64 + d) * LFULL + pos] = f2bf(cv[si]);
  }
}

DI int lds_byte(int r, int c) { const int st = (r >> 4) * 2 + (c >> 5), rr = r & 15, cc = c & 31, ob = rr * 64 + cc * 2; return st * 1024 + (ob ^ (((ob >> 9) & 1) << 5)); }
DI void stage_rc(int b, int& R, int& C) { const int st = b >> 10, sb = b & 1023, swz = sb ^ (((sb >> 9) & 1) << 5); R = (st >> 1) * 16 + (swz >> 6); C = (st & 1) * 32 + ((swz & 63) >> 1); }

template <int ROWS>
DI void stage_tile(const bf16_t* __restrict__ g, int ld, char* lds, int tid) {
#pragma unroll
  for (int i = 0; i < ROWS / 32; i++) {
    const int b = tid * 16 + i * 4096;
    int R, C;
    stage_rc(b, R, C);
    __builtin_amdgcn_global_load_lds((const unsigned*)(g + (size_t)R * ld + C), (unsigned*)(lds + b), 16, 0, 0);
  }
}

template <int NI>
DI void gemm_mainloop(const bf16_t* __restrict__ A, int lda, const bf16_t* __restrict__ Bt, int ldb, int K, int m0, int n0, bf16_t* smb, f32x4 (&acc)[4][NI]) {
  char* sm = (char*)smb;
  const int tid = tidx(), lane = tid & 63, wid = tid >> 6, wm = wid >> 1, wn = wid & 1, lr = lane & 15, quad = lane >> 4;
  const bf16_t* ga = A + (size_t)m0 * lda;
  const bf16_t* gb = Bt + (size_t)n0 * ldb;
  int offA[4][2], offB[NI][2];
#pragma unroll
  for (int ks = 0; ks < 2; ks++) {
#pragma unroll
    for (int mi = 0; mi < 4; mi++) offA[mi][ks] = lds_byte(wm * 64 + mi * 16 + lr, ks * 32 + quad * 8);
#pragma unroll
    for (int ni = 0; ni < NI; ni++) offB[ni][ks] = 16384 + lds_byte(wn * 16 * NI + ni * 16 + lr, ks * 32 + quad * 8);
  }
  __syncthreads();
  stage_tile<128>(ga, lda, sm, tid);
  stage_tile<32 * NI>(gb, ldb, sm + 16384, tid);
  asm volatile("s_waitcnt vmcnt(0)" ::: "memory");
  __syncthreads();
  const int nk = K >> 6;
  for (int kt = 0; kt < nk; kt++) {
    const int cur = kt & 1;
    if (kt + 1 < nk) {
      char* nb = sm + (cur ^ 1) * 32768;
      stage_tile<128>(ga + (kt + 1) * 64, lda, nb, tid);
      stage_tile<32 * NI>(gb + (kt + 1) * 64, ldb, nb + 16384, tid);
    }
    const char* cb = sm + cur * 32768;
#pragma unroll
    for (int ks = 0; ks < 2; ks++) {
      bf16x8 af[4], bfr[NI];
#pragma unroll
      for (int mi = 0; mi < 4; mi++) af[mi] = *(const bf16x8*)(cb + offA[mi][ks]);
#pragma unroll
      for (int ni = 0; ni < NI; ni++) bfr[ni] = *(const bf16x8*)(cb + offB[ni][ks]);
#pragma unroll
      for (int mi = 0; mi < 4; mi++)
#pragma unroll
        for (int ni = 0; ni < NI; ni++) acc[mi][ni] = MFMA16(af[mi], bfr[ni], acc[mi][ni]);
    }
    asm volatile("s_waitcnt vmcnt(0)" ::: "memory");
    __syncthreads();
  }
}

template <int MI, int NI>
DI void gemm_mainloop3(const bf16_t* __restrict__ A, int lda, const bf16_t* __restrict__ Bt, int ldb, int K, int m0, int n0, char* sm, f32x4 (&acc)[MI][NI]) {
  constexpr int A_BYTES = 32 * MI * 64, B_BYTES = 32 * NI * 64, STAGE = A_BYTES + B_BYTES;
  static_assert(3 * STAGE <= SMEM_BYTES, "LDS");
  const int tid = tidx(), lane = tid & 63, wid = tid >> 6, wm = wid >> 1, wn = wid & 1, lr = lane & 15, quad = lane >> 4;
  const int sb = (tid * 16) & 1023, swz = sb ^ (((sb >> 9) & 1) << 5), rr = swz >> 6, cc = (swz & 63) >> 1;
  const bf16_t* ga = A + (size_t)(m0 + wid * 16 + rr) * lda + cc;
  const bf16_t* gb = Bt + (size_t)(n0 + wid * 16 + rr) * ldb + cc;
  const int lane_off = (lr * 64 + quad * 16) ^ (((lr >> 3) & 1) << 5);
  const int offA = (wm * MI) * 1024 + lane_off, offB = A_BYTES + (wn * NI) * 1024 + lane_off;
#define G3_STAGE(buf_, kt_) do { char* d_ = sm + (buf_) * STAGE + tid * 16; const int ko_ = (kt_) * 32; \
    _Pragma("unroll") for (int i = 0; i < MI / 2; i++) __builtin_amdgcn_global_load_lds((const unsigned*)(ga + (size_t)(i * 64) * lda + ko_), (unsigned*)(d_ + i * 4096), 16, 0, 0); \
    _Pragma("unroll") for (int i = 0; i < NI / 2; i++) __builtin_amdgcn_global_load_lds((const unsigned*)(gb + (size_t)(i * 64) * ldb + ko_), (unsigned*)(d_ + A_BYTES + i * 4096), 16, 0, 0); \
  } while (0)
  const int nk = K >> 5;
  __syncthreads();
  G3_STAGE(0, 0);
  G3_STAGE(1, 1);
  int cur = 0;
  for (int kt = 0; kt < nk; kt++) {
    if (kt + 1 < nk) asm volatile("s_waitcnt vmcnt(%0)" ::"n"(MI / 2 + NI / 2) : "memory");
    else asm volatile("s_waitcnt vmcnt(0)" ::: "memory");
    __builtin_amdgcn_s_barrier();
    asm volatile("" ::: "memory");
    const char* cb = sm + cur * STAGE;
    bf16x8 af[MI], bfr[NI];
#pragma unroll
    for (int mi = 0; mi < MI; mi++) af[mi] = *(const bf16x8*)(cb + offA + mi * 1024);
#pragma unroll
    for (int ni = 0; ni < NI; ni++) bfr[ni] = *(const bf16x8*)(cb + offB + ni * 1024);
    if (kt + 2 < nk) { const int nb = cur >= 1 ? cur - 1 : 2; G3_STAGE(nb, kt + 2); }
#pragma unroll
    for (int mi = 0; mi < MI; mi++)
#pragma unroll
      for (int ni = 0; ni < NI; ni++) acc[mi][ni] = MFMA16(af[mi], bfr[ni], acc[mi][ni]);
    cur = cur == 2 ? 0 : cur + 1;
  }
#undef G3_STAGE
}

template <int MI, int NI>
DI void zero_acc2(f32x4 (&acc)[MI][NI]) {
#pragma unroll
  for (int i = 0; i < MI; i++)
#pragma unroll
    for (int j = 0; j < NI; j++) acc[i][j] = (f32x4){0.f, 0.f, 0.f, 0.f};
}

template <int NI>
DI void zero_acc(f32x4 (&acc)[4][NI]) {
#pragma unroll
  for (int i = 0; i < 4; i++)
#pragma unroll
    for (int j = 0; j < NI; j++) acc[i][j] = (f32x4){0.f, 0.f, 0.f, 0.f};
}

DI bool tile_map(int item, int MT, int NT, int& mt, int& nt) {
  const int r = item >> 9, within = item & 511, x = within & 7, q = within >> 3;
  const int patch = r * 8 + x, pmn = MT >> 3;
  mt = (patch % pmn) * 8 + (q & 7);
  nt = (patch / pmn) * 8 + (q >> 3);
  return nt < NT;
}

constexpr int GEMM_IN_N = 48 * 53;

DI void gemm_in_item(CP P, int l, int item, char* smem) {
  const int mt = item % 48, nt = item / 48;
  const int m0 = mt * 256, n0 = nt * 128;
  f32x4 acc[8][4];
  zero_acc2<8, 4>(acc);
  gemm_mainloop3<8, 4>(P->h, DM, P->wt_in + (size_t)l * NCOLP * 1024, 1024, 1024, m0, n0, smem, acc);
  const int tid = tidx(), lane = tid & 63, wid = tid >> 6, wm = wid >> 1, wn = wid & 1, lr = lane & 15, quad = lane >> 4;
  const int row0 = m0 + wm * 128, col0 = n0 + wn * 64;
  const int w64 = col0 >> 6;
  if (w64 < 24) {
#pragma unroll
    for (int mi = 0; mi < 8; mi++)
#pragma unroll
      for (int j = 0; j < 4; j++) {
        const size_t row = row0 + mi * 16 + quad * 4 + j;
#pragma unroll
        for (int ni = 0; ni < 4; ni++) P->qkv_raw[row * 1536 + w64 * 64 + ni * 16 + lr] = f2bf(acc[mi][ni][j]);
      }
  } else if (w64 < 32) {
#pragma unroll
    for (int mi = 0; mi < 8; mi++)
#pragma unroll
      for (int j = 0; j < 4; j++) {
        const size_t row = row0 + mi * 16 + quad * 4 + j;
#pragma unroll
        for (int ni = 0; ni < 4; ni++) P->z[row * 512 + (w64 - 24) * 64 + ni * 16 + lr] = f2bf(acc[mi][ni][j]);
      }
  } else if (w64 == 32) {
#pragma unroll
    for (int mi = 0; mi < 8; mi++)
#pragma unroll
      for (int j = 0; j < 4; j++) {
        const size_t row = row0 + mi * 16 + quad * 4 + j;
#pragma unroll
        for (int ni = 0; ni < 2; ni++) P->ba[row * 32 + ni * 16 + lr] = acc[mi][ni][j];
      }
  } else if (w64 < 57) {
    const int hidx = w64 - 33;
    const int typeC = hidx >= 12;
    const int hh = typeC ? hidx - 12 : hidx;
    const bool isq = hh < 8, isk = (hh == 8 || hh == 9), isv = hh >= 10;
    const int kvh = isk ? hh - 8 : (isv ? hh - 10 : 0);
    const bool latent = row0 >= NCTX;
    const float* qn = P->qk_norm + ((size_t)l * 4 + (typeC ? 2 : 0) + (isk ? 1 : 0)) * 64;
    float qw[4];
#pragma unroll
    for (int ni = 0; ni < 4; ni++) qw[ni] = qn[ni * 16 + lr];
#pragma unroll
    for (int mi = 0; mi < 8; mi++)
#pragma unroll
      for (int j = 0; j < 4; j++) {
        const int row = row0 + mi * 16 + quad * 4 + j;
        float val[4];
#pragma unroll
        for (int ni = 0; ni < 4; ni++) val[ni] = acc[mi][ni][j];
        if (!isv) {
          float ss = val[0] * val[0] + val[1] * val[1] + val[2] * val[2] + val[3] * val[3];
          ss += __shfl_xor(ss, 1); ss += __shfl_xor(ss, 2); ss += __shfl_xor(ss, 4); ss += __shfl_xor(ss, 8);
          const float rstd = rsqrtf(ss * (1.f / 64.f) + EPS);
#pragma unroll
          for (int ni = 0; ni < 4; ni++) val[ni] = val[ni] * rstd * qw[ni];
        }
        if (!latent) {
          const int b = row >> 8, t = row & 255;
          if (isq) {
            bf16_t* q = (typeC ? P->qC : P->qB) + (size_t)row * 512 + hh * 64;
#pragma unroll
            for (int ni = 0; ni < 4; ni++) q[ni * 16 + lr] = f2bf(val[ni] * QSCALE);
          } else if (isk) {
            bf16_t* kc = (typeC ? P->kcC : P->kcB) + ((size_t)(b * 2 + kvh) * 256 + t) * 64;
            float* ko = P->out + (typeC ? OUT_KW : OUT_KG) + (((size_t)(b * 4 + l) * 256 + t) * 2 + kvh) * 64;
#pragma unroll
            for (int ni = 0; ni < 4; ni++) { kc[ni * 16 + lr] = f2bf(val[ni]); ko[ni * 16 + lr] = val[ni]; }
          } else {
            bf16_t* vt = (typeC ? P->vtcC : P->vtcB) + (size_t)(b * 2 + kvh) * 64 * 256 + t;
            float* vo = P->out + (typeC ? OUT_VW : OUT_VG) + (((size_t)(b * 4 + l) * 256 + t) * 2 + kvh) * 64;
#pragma unroll
            for (int ni = 0; ni < 4; ni++) { vt[(size_t)(ni * 16 + lr) * 256] = f2bf(val[ni]); vo[ni * 16 + lr] = val[ni]; }
          }
        } else {
          const int b = (row - NCTX) >> 12, t = (row - NCTX) & 4095;
          if (!isv) {
            const float c0 = P->ropec[t * 32 + lr], c1 = P->ropec[t * 32 + 16 + lr];
            const float s0 = P->ropes[t * 32 + lr], s1 = P->ropes[t * 32 + 16 + lr];
            const float x10 = val[0], x11 = val[1], x20 = val[2], x21 = val[3];
            val[0] = x10 * c0 - x20 * s0; val[2] = x20 * c0 + x10 * s0;
            val[1] = x11 * c1 - x21 * s1; val[3] = x21 * c1 + x11 * s1;
          }
          if (isq) {
            bf16_t* q = (typeC ? P->qC : P->qB) + (size_t)row * 512 + hh * 64;
#pragma unroll
            for (int ni = 0; ni < 4; ni++) q[ni * 16 + lr] = f2bf(val[ni] * QSCALE);
          } else if (isk) {
            bf16_t* kf = (typeC ? P->kfC : P->kfB) + ((size_t)(b * 2 + kvh) * LFULL + 512 + t) * 64;
#pragma unroll
            for (int ni = 0; ni < 4; ni++) kf[ni * 16 + lr] = f2bf(val[ni]);
          } else {
            bf16_t* vt = (typeC ? P->vtfC : P->vtfB) + (size_t)(b * 2 + kvh) * 64 * LFULL + 512 + t;
#pragma unroll
            for (int ni = 0; ni < 4; ni++) vt[(size_t)(ni * 16 + lr) * LFULL] = f2bf(val[ni]);
          }
        }
      }
  } else if (w64 < 105) {
#pragma unroll
    for (int mi = 0; mi < 8; mi++)
#pragma unroll
      for (int j = 0; j < 4; j++) {
        const size_t row = row0 + mi * 16 + quad * 4 + j;
#pragma unroll
        for (int ni = 0; ni < 4; ni++) P->gates[row * 3072 + (w64 - 57) * 64 + ni * 16 + lr] = f2bf(sigmoidf_(acc[mi][ni][j]));
      }
  }
}

constexpr int GEMM_D_N = 96 * 8;
constexpr int GEMM_BR_N = 96 * 16;

DI void gemm_br_item(CP P, int l, int item, char* smem) {
  const int mt = item % 96, nt = item / 96;
  const int m0 = mt * 128, n0 = nt * 64;
  const int tid = tidx(), lane = tid & 63, wid = tid >> 6, wm = wid >> 1, wn = wid & 1, lr = lane & 15, quad = lane >> 4;
  const int row0 = m0 + wm * 64, col0 = n0 + wn * 32;
  f32x4 tot[4][2];
  zero_acc<2>(tot);
#pragma unroll 1
  for (int br = 0; br < 3; br++) {
    f32x4 acc[4][2];
    zero_acc<2>(acc);
    const bf16_t* A = br == 0 ? P->ya : br == 1 ? P->yb : P->yc;
    gemm_mainloop<2>(A, 512, P->wt_br + (size_t)(l * 3 + br) * 1024 * 512, 512, 512, m0, n0, (bf16_t*)smem, acc);
#pragma unroll
    for (int mi = 0; mi < 4; mi++)
#pragma unroll
      for (int j = 0; j < 4; j++) {
        const size_t row = row0 + mi * 16 + quad * 4 + j;
#pragma unroll
        for (int ni = 0; ni < 2; ni++) tot[mi][ni][j] += bf2f(P->gates[row * 3072 + br * 1024 + col0 + ni * 16 + lr]) * acc[mi][ni][j];
      }
  }
#pragma unroll
  for (int mi = 0; mi < 4; mi++)
#pragma unroll
    for (int j = 0; j < 4; j++) {
      const size_t row = row0 + mi * 16 + quad * 4 + j;
#pragma unroll
      for (int ni = 0; ni < 2; ni++) P->h[row * DM + col0 + ni * 16 + lr] = f2bf(tot[mi][ni][j]);
    }
}

constexpr int GEMM_RES_N = 1024;
template <int NI>
DI void gemm_res_tile(CP P, int l, char* smem, const bf16_t* A, int K, const bf16_t* Bt, int gate_off, int m0, int n0) {
  f32x4 acc[4][NI];
  zero_acc<NI>(acc);
  gemm_mainloop<NI>(A, K, Bt, K, K, m0, n0, (bf16_t*)smem, acc);
  const int tid = tidx(), lane = tid & 63, wid = tid >> 6, wm = wid >> 1, wn = wid & 1, lr = lane & 15, quad = lane >> 4;
  const int row0 = m0 + wm * 64, col0 = n0 + wn * 16 * NI;
  const float* g = P->mods + ((size_t)l * 3 + mod_index(row0)) * 6144 + gate_off + col0;
  float gv[NI];
#pragma unroll
  for (int ni = 0; ni < NI; ni++) gv[ni] = g[ni * 16 + lr];
#pragma unroll
  for (int mi = 0; mi < 4; mi++)
#pragma unroll
    for (int j = 0; j < 4; j++) {
      const size_t row = row0 + mi * 16 + quad * 4 + j;
#pragma unroll
      for (int ni = 0; ni < NI; ni++) {
        float* xp = P->out + row * DM + col0 + ni * 16 + lr;
        *xp = *xp + gv[ni] * acc[mi][ni][j];
      }
    }
}
DI void gemm_res_item(CP P, int l, int item, char* smem, const bf16_t* A, int K, const bf16_t* Bt, int gate_off) {
  if (item < 512) {
    gemm_res_tile<4>(P, l, smem, A, K, Bt, gate_off, (item % 96) * 128, (item / 96) * 128);
  } else {
    const int hi = item - 512, tile = 512 + (hi >> 1);
    gemm_res_tile<2>(P, l, smem, A, K, Bt, gate_off, (tile % 96) * 128, (tile / 96) * 128 + (hi & 1) * 64);
  }
}

constexpr int GEMM_FF2R_N = 48 * 8;
DI void gemm_res_ring_item(CP P, int l, int item, char* smem, const bf16_t* A, int K, const bf16_t* Bt, int gate_off) {
  const int mt = item % 48, nt = item / 48;
  const int m0 = mt * 256, n0 = nt * 128;
  f32x4 acc[8][4];
  zero_acc2<8, 4>(acc);
  gemm_mainloop3<8, 4>(A, K, Bt, K, K, m0, n0, smem, acc);
  const int tid = tidx(), lane = tid & 63, wid = tid >> 6, wm = wid >> 1, wn = wid & 1, lr = lane & 15, quad = lane >> 4;
  const int row0 = m0 + wm * 128, col0 = n0 + wn * 64;
  const float* g = P->mods + ((size_t)l * 3 + mod_index(row0)) * 6144 + gate_off + col0;
  float gv[4];
#pragma unroll
  for (int ni = 0; ni < 4; ni++) gv[ni] = g[ni * 16 + lr];
#pragma unroll
  for (int mi = 0; mi < 8; mi++)
#pragma unroll
    for (int j = 0; j < 4; j++) {
      const size_t row = row0 + mi * 16 + quad * 4 + j;
#pragma unroll
      for (int ni = 0; ni < 4; ni++) {
        float* xp = P->out + row * DM + col0 + ni * 16 + lr;
        *xp = *xp + gv[ni] * acc[mi][ni][j];
      }
    }
}

constexpr int GEMM_FF1_N = 48 * 32;
DI void gemm_ff1_item(CP P, int l, int item, char* smem) {
  int mt, nt;
  tile_map(item, 48, 32, mt, nt);
  const int m0 = mt * 256, n0 = nt * 128;
  f32x4 acc[8][4];
  zero_acc2<8, 4>(acc);
  gemm_mainloop3<8, 4>(P->h, DM, P->wt_ff1 + (size_t)l * DFF * 1024, 1024, 1024, m0, n0, smem, acc);
  const int tid = tidx(), lane = tid & 63, wid = tid >> 6, wm = wid >> 1, wn = wid & 1, lr = lane & 15, quad = lane >> 4;
  const int row0 = m0 + wm * 128, col0 = n0 + wn * 64;
#pragma unroll
  for (int mi = 0; mi < 8; mi++)
#pragma unroll
    for (int j = 0; j < 4; j++) {
      const size_t row = row0 + mi * 16 + quad * 4 + j;
#pragma unroll
      for (int ni = 0; ni < 4; ni++) {
        const float r = fmaxf(acc[mi][ni][j], 0.f);
        P->f[row * DFF + col0 + ni * 16 + lr] = f2bf(r * r);
      }
    }
}

#define MFMA16K16(a, b, c) __builtin_amdgcn_mfma_f32_16x16x16bf16_1k((a), (b), (c), 0, 0, 0)
DI unsigned bf16_sw(float f) { unsigned u = __float_as_uint(f); u += 0x7fffu + ((u >> 16) & 1u); return u >> 16; }
DI bf16x4 pack4(float x0, float x1, float x2, float x3) {
  typedef __attribute__((ext_vector_type(2))) unsigned u32x2_t;
  u32x2_t t;
  t[0] = bf16_sw(x0) | (bf16_sw(x1) << 16);
  t[1] = bf16_sw(x2) | (bf16_sw(x3) << 16);
  return __builtin_bit_cast(bf16x4, t);
}

DI void gdn_dinv(const float* M, float* Dv, int tid) {
  const int dir = tid >> 6, blk = (tid >> 4) & 3, c = tid & 15;
  const float* Mb = M + (blk * 16) * 64 + blk * 16;
  float y[16];
  if (dir == 0) {
#pragma unroll
    for (int r = 0; r < 16; r++) {
      float a = (r == c) ? 1.f : 0.f;
#pragma unroll
      for (int j = 0; j < 16; j++) if (j < r) a -= Mb[r * 64 + j] * y[j];
      y[r] = a;
    }
  } else {
#pragma unroll
    for (int rr = 0; rr < 16; rr++) {
      const int r = 15 - rr;
      float a = (r == c) ? 1.f : 0.f;
#pragma unroll
      for (int j = 0; j < 16; j++) if (j > r) a -= Mb[r * 64 + j] * y[j];
      y[r] = a;
    }
  }
  float* d = Dv + (dir * 4 + blk) * 256 + c;
#pragma unroll
  for (int r = 0; r < 16; r++) d[r * 16] = y[r];
}

DI void gdn_solve_blocked(CP P, const float* M, const float* Dv, const float* vec, const bf16_t* kb, const bf16_t* vb, int tid, int n0, int h) {
  const int lane = tid & 63, wid = tid >> 6, lr = lane & 15, quad = lane >> 4;
  const int dir = wid >> 1, ch = wid & 1;
  const float* bvec = vec + dir * 64;
  const float* egv = vec + 256 + dir * 64;
  const bf16_t* src = ch ? kb : vb;
  bf16_t* dst = (ch ? P->gw : P->gu) + (size_t)dir * NTOK * 512 + (size_t)n0 * 512 + h * 64;
  bf16x4 XB[4][4];
#pragma unroll
  for (int s = 0; s < 4; s++) {
    const int i = dir ? 3 - s : s;
    f32x4 T[4];
#pragma unroll
    for (int j = 0; j < 4; j++) {
      const int p = i * 16 + quad * 4 + j;
      const float sc = bvec[p] * (ch ? egv[p] : 1.f);
#pragma unroll
      for (int nt = 0; nt < 4; nt++) T[nt][j] = sc * bf2f(src[p * 72 + nt * 16 + lr]);
    }
#pragma unroll
    for (int q = 0; q < 4; q++) {
      if (q < s) {
        const int jb = dir ? 3 - q : q;
        const float4 m4 = *(const float4*)(M + (i * 16 + lr) * 64 + jb * 16 + quad * 4);
        const bf16x4 am = pack4(-m4.x, -m4.y, -m4.z, -m4.w);
#pragma unroll
        for (int nt = 0; nt < 4; nt++) T[nt] = MFMA16K16(am, XB[q][nt], T[nt]);
      }
    }
    const float4 d4 = *(const float4*)(Dv + ((dir * 4 + i) * 16 + lr) * 16 + quad * 4);
    const bf16x4 ad = pack4(d4.x, d4.y, d4.z, d4.w);
#pragma unroll
    for (int nt = 0; nt < 4; nt++) {
      const bf16x4 tb = pack4(T[nt][0], T[nt][1], T[nt][2], T[nt][3]);
      const f32x4 X = MFMA16K16(ad, tb, ((f32x4){0.f, 0.f, 0.f, 0.f}));
      XB[s][nt] = pack4(X[0], X[1], X[2], X[3]);
#pragma unroll
      for (int j = 0; j < 4; j++) dst[(size_t)(i * 16 + quad * 4 + j) * 512 + nt * 16 + lr] = (bf16_t)bf16_sw(X[j]);
    }
  }
}

constexpr int GDNA_N = 192 * 8;

DI void gdn_a_item(CP P, int l, int item, char* smem) {
  const int tid = tidx(), lane = tid & 63, wid = tid >> 6, lr = lane & 15, quad = lane >> 4;
  const int gcx = item >> 3, h = item & 7;
  const int n0 = gcx * 64;
  int s0, s1;
  if (n0 < NCTX) { s0 = n0 & ~255; s1 = s0 + 256; } else { s0 = NCTX + ((n0 - NCTX) & ~4095); s1 = s0 + 4096; }
  bf16_t* kb = (bf16_t*)smem;
  bf16_t* vb = kb + 4608;
  float* M = (float*)(smem + 18432);
  float* vec = M + 4096;
  bf16_t* qb = (bf16_t*)(smem + 36352);
  float* cwl = (float*)(smem + 36352 + 9216);
  float* Dv = (float*)(smem + 36352);
  __syncthreads();
  for (int i = tid; i < 960; i += 256) {
    const int j = i / 192, cc = i % 192, sect = cc >> 6;
    cwl[i] = P->conv[((size_t)l * 5 + j) * 1536 + sect * 512 + h * 64 + (cc & 63)];
  }
  if (wid < 2) {
    const int dir = wid, pp = lane;
    const size_t n = (size_t)n0 + pp;
    const float braw = P->ba[n * 32 + dir * 8 + h];
    const float araw = P->ba[n * 32 + 16 + dir * 8 + h] + P->dt_bias[l * 16 + dir * 8 + h];
    const float sp = araw > 20.f ? araw : log1pf(expf(araw));
    float x = -expf(P->a_log[l * 16 + dir * 8 + h]) * sp;
#pragma unroll
    for (int o = 1; o < 64; o <<= 1) {
      const float yu = __shfl_up(x, o), yd = __shfl_down(x, o);
      if (dir ? (lane + o < 64) : (lane >= o)) x += dir ? yd : yu;
    }
    vec[dir * 64 + pp] = sigmoidf_(braw);
    vec[128 + dir * 64 + pp] = x;
    vec[256 + dir * 64 + pp] = __expf(x);
  }
  __syncthreads();
  {
    const int r = tid >> 2, part = tid & 3;
    const int n = n0 + r;
    float acc[3][16];
#pragma unroll
    for (int sct = 0; sct < 3; sct++)
#pragma unroll
      for (int i = 0; i < 16; i++) acc[sct][i] = 0.f;
#pragma unroll
    for (int j = 0; j < 5; j++) {
      const int nn = n + j - 2;
      if (nn >= s0 && nn < s1) {
#pragma unroll
        for (int sct = 0; sct < 3; sct++) {
          union { uint4 u[2]; bf16_t b[16]; } x;
          const bf16_t* src = P->qkv_raw + (size_t)nn * 1536 + sct * 512 + h * 64 + part * 16;
          x.u[0] = *(const uint4*)src; x.u[1] = *(const uint4*)(src + 8);
          const float* cw = cwl + j * 192 + sct * 64 + part * 16;
#pragma unroll
          for (int i = 0; i < 16; i++) acc[sct][i] += cw[i] * bf2f(x.b[i]);
        }
      }
    }
#pragma unroll
    for (int sct = 0; sct < 3; sct++) {
      float ss = 0.f;
#pragma unroll
      for (int i = 0; i < 16; i++) { acc[sct][i] = siluf_(acc[sct][i]); ss += acc[sct][i] * acc[sct][i]; }
      if (sct < 2) {
        ss += __shfl_xor(ss, 1); ss += __shfl_xor(ss, 2);
        const float sc = rsqrtf(ss + EPS) * (sct == 0 ? 0.125f : 1.f);
#pragma unroll
        for (int i = 0; i < 16; i++) acc[sct][i] *= sc;
      }
      union { uint4 u[2]; unsigned w[8]; } o;
#pragma unroll
      for (int i = 0; i < 8; i++) o.w[i] = pack2(acc[sct][2 * i], acc[sct][2 * i + 1]);
      bf16_t* dl = (sct == 0 ? qb : sct == 1 ? kb : vb) + r * 72 + part * 16;
      *(uint4*)dl = o.u[0]; *(uint4*)(dl + 8) = o.u[1];
      if (sct == 0) { bf16_t* dg = P->gq + (size_t)n * 512 + h * 64 + part * 16; *(uint4*)dg = o.u[0]; *(uint4*)(dg + 8) = o.u[1]; }
    }
  }
  __syncthreads();
  {
    bf16x8 ak[2], aq[2];
#pragma unroll
    for (int ks = 0; ks < 2; ks++) {
      ak[ks] = *(const bf16x8*)(kb + (wid * 16 + lr) * 72 + ks * 32 + quad * 8);
      aq[ks] = *(const bf16x8*)(qb + (wid * 16 + lr) * 72 + ks * 32 + quad * 8);
    }
    const float* b0 = vec; const float* b1 = vec + 64; const float* G0 = vec + 128; const float* G1 = vec + 192;
#pragma unroll
    for (int ni = 0; ni < 4; ni++) {
      f32x4 ckk = (f32x4){0.f, 0.f, 0.f, 0.f}, cqk = (f32x4){0.f, 0.f, 0.f, 0.f};
#pragma unroll
      for (int ks = 0; ks < 2; ks++) {
        const bf16x8 bk = *(const bf16x8*)(kb + (ni * 16 + lr) * 72 + ks * 32 + quad * 8);
        ckk = MFMA16(ak[ks], bk, ckk);
        cqk = MFMA16(aq[ks], bk, cqk);
      }
      const int pp = ni * 16 + lr;
#pragma unroll
      for (int j = 0; j < 4; j++) {
        const int p = wid * 16 + quad * 4 + j;
        float m = 0.f, at0 = 0.f, at1 = 0.f;
        if (pp < p) { const float dec = __expf(G0[p] - G0[pp]); m = b0[p] * ckk[j] * dec; at0 = cqk[j] * dec; }
        else if (pp > p) { const float dec = __expf(G1[p] - G1[pp]); m = b1[p] * ckk[j] * dec; at1 = cqk[j] * dec; }
        else { at0 = cqk[j]; at1 = cqk[j]; }
        M[p * 64 + pp] = m;
        const size_t gi = ((size_t)n0 + p) * 512 + h * 64 + pp;
        P->gattn[gi] = f2bf(at0);
        P->gattn[(size_t)NTOK * 512 + gi] = f2bf(at1);
      }
    }
  }
  {
    const int d = tid >> 2, pg = tid & 3;
    union { uint4 u[2]; bf16_t b[16]; } o;
#pragma unroll
    for (int i = 0; i < 16; i++) o.b[i] = kb[(pg * 16 + i) * 72 + d];
    bf16_t* dg = P->gkT + ((size_t)item * 64 + d) * 64 + pg * 16;
    *(uint4*)dg = o.u[0]; *(uint4*)(dg + 8) = o.u[1];
  }
  if (tid < 128) {
    const int dir = tid >> 6, pp = tid & 63;
    const float glast = dir ? vec[192] : vec[128 + 63];
    const size_t vi = (size_t)dir * NTOK * 8 + ((size_t)n0 + pp) * 8 + h;
    P->geg[vi] = vec[256 + dir * 64 + pp];
    P->gks[vi] = __expf(glast - vec[128 + dir * 64 + pp]);
    if (pp == 0) P->ggl[dir * 1536 + item] = __expf(glast);
  }
  __syncthreads();
  if (tid < 128) gdn_dinv(M, Dv, tid);
  __syncthreads();
  gdn_solve_blocked(P, M, Dv, vec, kb, vb, tid, n0, h);
}

DI void attn_item(const bf16_t* __restrict__ Q, const bf16_t* __restrict__ Kp, const bf16_t* __restrict__ Vt, int vstride, int nA, int tb0, int tb1,
                  int qpos0, bool has_sink, float sinkv, bf16_t* __restrict__ Y, bf16_t* smb) {
  char* sm = (char*)smb;
  const int tid = tidx(), lane = tid & 63, wid = tid >> 6, lr = lane & 15, quad = lane >> 4;
  bf16x8 bq[2][2];
#pragma unroll
  for (int qt = 0; qt < 2; qt++)
#pragma unroll
    for (int ks = 0; ks < 2; ks++) bq[qt][ks] = *(const bf16x8*)(Q + (size_t)(wid * 32 + qt * 16 + lr) * 512 + ks * 32 + quad * 8);
  int offK[4][2], offV[4][2][2];
#pragma unroll
  for (int t = 0; t < 4; t++)
#pragma unroll
    for (int ks = 0; ks < 2; ks++) {
      offK[t][ks] = lds_byte(t * 16 + lr, ks * 32 + quad * 8);
      offV[t][ks][0] = 8192 + lds_byte(t * 16 + lr, ks * 32 + quad * 4);
      offV[t][ks][1] = 8192 + lds_byte(t * 16 + lr, ks * 32 + 16 + quad * 4);
    }
  f32x4 O[4][2];
#pragma unroll
  for (int dt = 0; dt < 4; dt++) { O[dt][0] = (f32x4){0.f, 0.f, 0.f, 0.f}; O[dt][1] = (f32x4){0.f, 0.f, 0.f, 0.f}; }
  float mrun[2];
  f32x4 lsum4[2];
  sinkv *= LOG2E;
  mrun[0] = mrun[1] = has_sink ? sinkv : -1e30f;
  lsum4[0] = lsum4[1] = (f32x4){0.f, 0.f, 0.f, 0.f};
  const int npairs = (nA + (tb1 - tb0)) >> 1, nAp = nA >> 1;
  __syncthreads();
  {
    const int t0 = (nAp > 0 ? 0 : tb0);
    stage_tile<64>(Kp + (size_t)t0 * 4096, 64, sm, tid);
    stage_tile<64>(Vt + t0 * 64, vstride, sm + 8192, tid);
    stage_tile<64>(Kp + (size_t)(t0 + 1) * 4096, 64, sm + 16384, tid);
    stage_tile<64>(Vt + (t0 + 1) * 64, vstride, sm + 24576, tid);
  }
  asm volatile("s_waitcnt vmcnt(0)" ::: "memory");
  __syncthreads();
  for (int ip = 0; ip < npairs; ip++) {
    const bool masked = ip >= nAp;
    const int tile0 = masked ? tb0 + 2 * (ip - nAp) : 2 * ip;
    const int cur = ip & 1;
    if (ip + 1 < npairs) {
      const int tn = (ip + 1 >= nAp) ? tb0 + 2 * (ip + 1 - nAp) : 2 * (ip + 1);
      char* nb = sm + (cur ^ 1) * 32768;
      stage_tile<64>(Kp + (size_t)tn * 4096, 64, nb, tid);
      stage_tile<64>(Vt + tn * 64, vstride, nb + 8192, tid);
      stage_tile<64>(Kp + (size_t)(tn + 1) * 4096, 64, nb + 16384, tid);
      stage_tile<64>(Vt + (tn + 1) * 64, vstride, nb + 24576, tid);
    }
#pragma unroll 1
    for (int sub = 0; sub < 2; sub++) {
    const int p0 = (tile0 + sub) * 64;
    const char* cb = sm + cur * 32768 + sub * 16384;
    f32x4 s[4][2];
    __builtin_amdgcn_s_setprio(1);
#pragma unroll
    for (int kt = 0; kt < 4; kt++) {
      const bf16x8 a0 = *(const bf16x8*)(cb + offK[kt][0]);
      const bf16x8 a1 = *(const bf16x8*)(cb + offK[kt][1]);
#pragma unroll
      for (int qt = 0; qt < 2; qt++) {
        f32x4 t = MFMA16(a0, bq[qt][0], ((f32x4){0.f, 0.f, 0.f, 0.f}));
        s[kt][qt] = MFMA16(a1, bq[qt][1], t);
      }
    }
    __builtin_amdgcn_s_setprio(0);
    if (masked) {
#pragma unroll
      for (int kt = 0; kt < 4; kt++)
#pragma unroll
        for (int qt = 0; qt < 2; qt++)
#pragma unroll
          for (int j = 0; j < 4; j++) {
            const int key = p0 + kt * 16 + quad * 4 + j;
            const int qp = qpos0 + wid * 32 + qt * 16 + lr;
            const int d = key - qp;
            if (d > 128 || d < -128) s[kt][qt][j] = -1e30f;
          }
    }
    float mx[2];
#pragma unroll
    for (int qt = 0; qt < 2; qt++) {
      const f32x4 m01 = __builtin_elementwise_max(s[0][qt], s[1][qt]);
      const f32x4 m23 = __builtin_elementwise_max(s[2][qt], s[3][qt]);
      const f32x4 m4 = __builtin_elementwise_max(m01, m23);
      float m = fmaxf(fmaxf(m4[0], m4[1]), fmaxf(m4[2], m4[3]));
      m = fmaxf(m, __shfl_xor(m, 16));
      m = fmaxf(m, __shfl_xor(m, 32));
      mx[qt] = m;
    }
    if (__any((mx[0] > mrun[0] + 8.f) || (mx[1] > mrun[1] + 8.f))) {
#pragma unroll
      for (int qt = 0; qt < 2; qt++) {
        const float mnew = fmaxf(mrun[qt], mx[qt]);
        const float alpha = __builtin_amdgcn_exp2f(mrun[qt] - mnew);
        mrun[qt] = mnew;
        lsum4[qt] *= alpha;
#pragma unroll
        for (int dt = 0; dt < 4; dt++) O[dt][qt] *= alpha;
      }
    }
#pragma unroll
    for (int qt = 0; qt < 2; qt++) {
      const float mr = mrun[qt];
#pragma unroll
      for (int kt = 0; kt < 4; kt++) {
        const f32x4 d = s[kt][qt] - mr;
        f32x4 pv;
        pv[0] = __builtin_amdgcn_exp2f(d[0]); pv[1] = __builtin_amdgcn_exp2f(d[1]); pv[2] = __builtin_amdgcn_exp2f(d[2]); pv[3] = __builtin_amdgcn_exp2f(d[3]);
        s[kt][qt] = pv;
        lsum4[qt] += pv;
      }
    }
    __builtin_amdgcn_s_setprio(1);
#pragma unroll
    for (int kk = 0; kk < 2; kk++) {
      bf16x8 bp[2];
#pragma unroll
      for (int qt = 0; qt < 2; qt++) {
        bp[qt] = pack8(s[2 * kk][qt][0], s[2 * kk][qt][1], s[2 * kk][qt][2], s[2 * kk][qt][3],
                       s[2 * kk + 1][qt][0], s[2 * kk + 1][qt][1], s[2 * kk + 1][qt][2], s[2 * kk + 1][qt][3]);
      }
#pragma unroll
      for (int dt = 0; dt < 4; dt++) {
        const bf16x4 v0 = *(const bf16x4*)(cb + offV[dt][kk][0]);
        const bf16x4 v1 = *(const bf16x4*)(cb + offV[dt][kk][1]);
        const bf16x8 av = __builtin_shufflevector(v0, v1, 0, 1, 2, 3, 4, 5, 6, 7);
#pragma unroll
        for (int qt = 0; qt < 2; qt++) O[dt][qt] = MFMA16(av, bp[qt], O[dt][qt]);
      }
    }
    __builtin_amdgcn_s_setprio(0);
    }
    asm volatile("s_waitcnt vmcnt(0)" ::: "memory");
    __syncthreads();
  }
#pragma unroll
  for (int qt = 0; qt < 2; qt++) {
    float lt = (lsum4[qt][0] + lsum4[qt][1]) + (lsum4[qt][2] + lsum4[qt][3]);
    lt += __shfl_xor(lt, 16);
    lt += __shfl_xor(lt, 32);
    if (has_sink) lt += __builtin_amdgcn_exp2f(sinkv - mrun[qt]);
    const float inv = 1.f / lt;
    bf16_t* yr = Y + (size_t)(wid * 32 + qt * 16 + lr) * 512;
#pragma unroll
    for (int dt = 0; dt < 4; dt++) {
      uint2 o;
      o.x = pack2(O[dt][qt][0] * inv, O[dt][qt][1] * inv);
      o.y = pack2(O[dt][qt][2] * inv, O[dt][qt][3] * inv);
      *(uint2*)(yr + dt * 16 + quad * 4) = o;
    }
  }
}

DI bf16x8 frag_perm(const bf16_t* base, int row, int kk, int quad) {
  const bf16_t* p = base + row * 72 + kk * 32 + quad * 4;
  const bf16x4 v0 = *(const bf16x4*)p;
  const bf16x4 v1 = *(const bf16x4*)(p + 16);
  return __builtin_shufflevector(v0, v1, 0, 1, 2, 3, 4, 5, 6, 7);
}
DI bf16x8 pack_c2(const f32x4& a, const f32x4& b) { return pack8(a[0], a[1], a[2], a[3], b[0], b[1], b[2], b[3]); }

DI void gdn_scan_item(CP P, int l, int seq, int h, int dir, char* smem) {
  const int tid = tidx(), lane = tid & 63, wid = tid >> 6, lr = lane & 15, quad = lane >> 4;
  const bool ctx = seq < 16;
  const int nch = ctx ? 4 : 64;
  const int n0 = ctx ? seq * 256 : NCTX + (seq - 16) * 4096;
  const int ch0 = n0 >> 6;
  bf16_t* sQ = (bf16_t*)smem;
  bf16_t* sKT = sQ + 4608;
  bf16_t* sW = sKT + 4608;
  bf16_t* sA = sW + 4608;
  bf16_t* sU = sA + 4608;
  float* sEg = (float*)(smem + 46080);
  float* sKs = sEg + 64;
  float* sGl = sKs + 64;
  f32x4 S[4];
  if (ctx) {
#pragma unroll
    for (int mi = 0; mi < 4; mi++) S[mi] = (f32x4){0.f, 0.f, 0.f, 0.f};
  } else {
    const float* src = P->state + ((((size_t)(seq - 16) * 4 + l) * 2 + dir) * 8 + h) * 4096;
#pragma unroll
    for (int mi = 0; mi < 4; mi++)
#pragma unroll
      for (int j = 0; j < 4; j++) S[mi][j] = src[(mi * 16 + quad * 4 + j) * 64 + wid * 16 + lr];
  }
  const size_t doff = (size_t)dir * NTOK * 512;
  uint4 pq0, pq1, pk0, pk1, pw0, pw1, pa0, pa1, pu0, pu1;
  float pv = 0.f;
  const int lrow = tid >> 3, lcol = (tid & 7) * 8;
#define GDN_ISSUE1(i_, Q_, K_, W_, A_, U_) { \
      const size_t ro = tb + (size_t)(lrow + 32 * (i_)) * 512 + lcol; \
      Q_ = *(const uint4*)(P->gq + ro); \
      K_ = *(const uint4*)(P->gkT + ((size_t)((ch0 + c__) * 8 + h) * 64 + lrow + 32 * (i_)) * 64 + lcol); \
      W_ = *(const uint4*)(P->gw + doff + ro); \
      A_ = *(const uint4*)(P->gattn + doff + ro); \
      U_ = *(const uint4*)(P->gu + doff + ro); }
#define GDN_ISSUE(c_) do { const int c__ = (c_); \
    const size_t tb = ((size_t)n0 + c__ * 64) * 512 + h * 64; \
    GDN_ISSUE1(0, pq0, pk0, pw0, pa0, pu0) \
    GDN_ISSUE1(1, pq1, pk1, pw1, pa1, pu1) \
    if (tid < 64) pv = P->geg[(size_t)dir * NTOK * 8 + ((size_t)n0 + c__ * 64 + tid) * 8 + h]; \
    else if (tid < 128) pv = P->gks[(size_t)dir * NTOK * 8 + ((size_t)n0 + c__ * 64 + tid - 64) * 8 + h]; \
    else if (tid == 128) pv = P->ggl[dir * 1536 + (ch0 + c__) * 8 + h]; \
  } while (0)
  GDN_ISSUE(dir ? nch - 1 : 0);
  for (int cc = 0; cc < nch; cc++) {
    const int c = dir ? nch - 1 - cc : cc;
    __syncthreads();
    {
      const int so0 = lrow * 72 + lcol, so1 = (lrow + 32) * 72 + lcol;
      *(uint4*)(sQ + so0) = pq0; *(uint4*)(sQ + so1) = pq1;
      *(uint4*)(sKT + so0) = pk0; *(uint4*)(sKT + so1) = pk1;
      *(uint4*)(sW + so0) = pw0; *(uint4*)(sW + so1) = pw1;
      *(uint4*)(sA + so0) = pa0; *(uint4*)(sA + so1) = pa1;
      *(uint4*)(sU + so0) = pu0; *(uint4*)(sU + so1) = pu1;
    }
    if (tid < 64) sEg[tid] = pv; else if (tid < 128) sKs[tid - 64] = pv; else if (tid == 128) sGl[0] = pv;
    __syncthreads();
    if (cc + 1 < nch) GDN_ISSUE(dir ? nch - 2 - cc : cc + 1);
    bf16x8 sB[2];
    sB[0] = pack_c2(S[0], S[1]);
    sB[1] = pack_c2(S[2], S[3]);
    f32x4 U[4], QS[4];
#pragma unroll
    for (int mi = 0; mi < 4; mi++) {
      f32x4 aw = (f32x4){0.f, 0.f, 0.f, 0.f}, aq = (f32x4){0.f, 0.f, 0.f, 0.f};
#pragma unroll
      for (int kk = 0; kk < 2; kk++) {
        aw = MFMA16(frag_perm(sW, mi * 16 + lr, kk, quad), sB[kk], aw);
        aq = MFMA16(frag_perm(sQ, mi * 16 + lr, kk, quad), sB[kk], aq);
      }
#pragma unroll
      for (int j = 0; j < 4; j++) U[mi][j] = bf2f(sU[(mi * 16 + quad * 4 + j) * 72 + wid * 16 + lr]) - aw[j];
      QS[mi] = aq;
    }
    bf16x8 uB[2], usB[2];
    {
      f32x4 t[4];
#pragma unroll
      for (int mi = 0; mi < 4; mi++)
#pragma unroll
        for (int j = 0; j < 4; j++) t[mi][j] = U[mi][j] * sKs[mi * 16 + quad * 4 + j];
      uB[0] = pack_c2(U[0], U[1]); uB[1] = pack_c2(U[2], U[3]);
      usB[0] = pack_c2(t[0], t[1]); usB[1] = pack_c2(t[2], t[3]);
    }
    bf16_t* og = P->obf + doff + ((size_t)n0 + c * 64) * 512 + h * 64 + wid * 16 + lr;
#pragma unroll
    for (int mi = 0; mi < 4; mi++) {
      f32x4 aa = (f32x4){0.f, 0.f, 0.f, 0.f};
#pragma unroll
      for (int kk = 0; kk < 2; kk++) aa = MFMA16(frag_perm(sA, mi * 16 + lr, kk, quad), uB[kk], aa);
#pragma unroll
      for (int j = 0; j < 4; j++) {
        const int pr = mi * 16 + quad * 4 + j;
        og[(size_t)pr * 512] = f2bf(sEg[pr] * QS[mi][j] + aa[j]);
      }
    }
    const float gl = sGl[0];
#pragma unroll
    for (int mi = 0; mi < 4; mi++) {
      f32x4 ak = (f32x4){0.f, 0.f, 0.f, 0.f};
#pragma unroll
      for (int kk = 0; kk < 2; kk++) ak = MFMA16(frag_perm(sKT, mi * 16 + lr, kk, quad), usB[kk], ak);
#pragma unroll
      for (int j = 0; j < 4; j++) S[mi][j] = gl * S[mi][j] + ak[j];
    }
  }
  if (ctx) {
    float* dst = P->out + OUT_ST + ((((size_t)seq * 4 + l) * 2 + dir) * 8 + h) * 4096;
#pragma unroll
    for (int mi = 0; mi < 4; mi++)
#pragma unroll
      for (int j = 0; j < 4; j++) dst[(mi * 16 + quad * 4 + j) * 64 + wid * 16 + lr] = S[mi][j];
  }
}

constexpr int MIX_GL = 32, MIX_BL = 512, MIX_CL = 512, MIX_GC = 256, MIX_BC = 256, MIX_CC = 256;
constexpr int MIX_N = MIX_GL + MIX_BL + MIX_CL + MIX_GC + MIX_BC + MIX_CC;

DI void mix_item(CP P, int l, int item, char* smem) {
  if (item < MIX_GL) { gdn_scan_item(P, l, 16 + (item >> 4), (item >> 1) & 7, item & 1, smem); return; }
  item -= MIX_GL;
  if (item < MIX_BL + MIX_CL) {
    const int typeC = item >= MIX_BL;
    const int i = typeC ? item - MIX_BL : item;
    const int b = i >> 8, head = (i >> 5) & 7, qb = i & 31, kvh = head >> 2;
    const size_t tok0 = (size_t)NCTX + b * 4096 + qb * 128;
    const bf16_t* Q = (typeC ? P->qC : P->qB) + tok0 * 512 + head * 64;
    const bf16_t* Kp = (typeC ? P->kfC : P->kfB) + (size_t)(b * 2 + kvh) * LFULL * 64;
    const bf16_t* Vt = (typeC ? P->vtfC : P->vtfB) + (size_t)(b * 2 + kvh) * 64 * LFULL;
    bf16_t* Y = (typeC ? P->yc : P->yb) + tok0 * 512 + head * 64;
    if (!typeC) {
      attn_item(Q, Kp, Vt, LFULL, 72, 0, 0, 0, false, 0.f, Y, (bf16_t*)smem);
    } else {
      const int start = qb * 128;
      const int lo = start - 128 < 0 ? 0 : start - 128;
      const int hi = start + 256 > 4096 ? 4096 : start + 256;
      attn_item(Q, Kp, Vt, LFULL, 8, (512 + lo) >> 6, (512 + hi) >> 6, 512 + start, true, P->sink[l * 8 + head], Y, (bf16_t*)smem);
    }
    return;
  }
  item -= MIX_BL + MIX_CL;
  if (item < MIX_GC) { gdn_scan_item(P, l, item >> 4, (item >> 1) & 7, item & 1, smem); return; }
  item -= MIX_GC;
  {
    const int typeC = item >= MIX_BC;
    const int i = typeC ? item - MIX_BC : item;
    const int b = i >> 4, head = (i >> 1) & 7, qb = i & 1, kvh = head >> 2;
    const size_t tok0 = (size_t)b * 256 + qb * 128;
    const bf16_t* Q = (typeC ? P->qC : P->qB) + tok0 * 512 + head * 64;
    const bf16_t* Kp = (typeC ? P->kcC : P->kcB) + (size_t)(b * 2 + kvh) * 256 * 64;
    const bf16_t* Vt = (typeC ? P->vtcC : P->vtcB) + (size_t)(b * 2 + kvh) * 64 * 256;
    bf16_t* Y = (typeC ? P->yc : P->yb) + tok0 * 512 + head * 64;
    attn_item(Q, Kp, Vt, 256, 4, 0, 0, 0, typeC != 0, typeC ? P->sink[l * 8 + head] : 0.f, Y, (bf16_t*)smem);
  }
}

constexpr int GDNOUT_N = NTOK / 4;
DI void gdnout_item(CP P, int l, int item) {
  const int tid = tidx(), lane = tid & 63, wid = tid >> 6;
  const size_t base = (size_t)(item * 4 + wid) * 512 + lane;
  float o[8], zz[8];
#pragma unroll
  for (int hh = 0; hh < 8; hh++) {
    const size_t idx = base + hh * 64;
    o[hh] = bf2f(P->obf[idx]) + bf2f(P->obf[(size_t)NTOK * 512 + idx]);
    zz[hh] = bf2f(P->z[idx]);
  }
  const float an = P->a_norm[l * 64 + lane];
#pragma unroll
  for (int hh = 0; hh < 8; hh++) {
    const float ss = wave_sum(o[hh] * o[hh]);
    const float on = o[hh] * rsqrtf(ss * (1.f / 64.f) + EPS) * an;
    P->ya[base + hh * 64] = f2bf(on * siluf_(zz[hh]));
  }
}

#define XB_TMO      128
#define XB_XCNT(j)  (256  + 64 * (j))
#define XB_XSUB(j)  (1280 + 64 * (j))
#define XB_XGEN(j)  (2304 + 64 * (j))
#define XB_TOP      3328
#define XB_TOPGEN   3392
#define XCD_BAR_WORDS 3456
#define XB_SPIN_CAP (1u << 22)
#define LAS __attribute__((address_space(3)))
DI unsigned xb_ld(unsigned* p) { return __hip_atomic_load(p, __ATOMIC_RELAXED, __HIP_MEMORY_SCOPE_AGENT); }
DI unsigned xb_add(unsigned* p, unsigned v) { return __hip_atomic_fetch_add(p, v, __ATOMIC_RELAXED, __HIP_MEMORY_SCOPE_AGENT); }
DI unsigned xb_xcc_id() { return (unsigned)__builtin_amdgcn_s_getreg((3 << 11) | 20) & 0xFu; }
#define XB_SPIN(cond, bar) do { unsigned _sp = 0; while (cond) { __builtin_amdgcn_s_sleep(1); \
    if ((++_sp & 255u) == 0u) { if (xb_ld(&(bar)[XB_TMO])) break; if (_sp > XB_SPIN_CAP) { atomicAdd(&(bar)[XB_TMO], 1u); break; } } } } while (0)
struct XcdBarrier { unsigned* bar; unsigned x; volatile LAS unsigned* st; };
DI XcdBarrier xcd_barrier_post(unsigned* bar, volatile LAS unsigned* st) {
  XcdBarrier b; b.bar = bar; b.x = xb_xcc_id(); b.st = st;
  if (threadIdx.x == 0) (void)xb_add(&bar[XB_XCNT(b.x)], 1u);
  return b;
}
DI void xcd_barrier_complete(unsigned* bar, unsigned x, unsigned& nloc, unsigned& nx) {
  const unsigned G = gridDim.x * gridDim.y * gridDim.z;
  unsigned sum, cnt, mine, sp = 0u;
  for (;;) {
    sum = 0u; cnt = 0u; mine = 0u;
#pragma unroll
    for (unsigned j = 0; j < 16; ++j) { const unsigned c = xb_ld(&bar[XB_XCNT(j)]); sum += c; cnt += (c > 0u) ? 1u : 0u; mine = (j == x) ? c : mine; }
    if (sum == G) break;
    __builtin_amdgcn_s_sleep(1);
    if ((++sp & 255u) == 0u) { if (xb_ld(&bar[XB_TMO])) break; if (sp > XB_SPIN_CAP) { atomicAdd(&bar[XB_TMO], 1u); break; } }
  }
  nloc = mine > 0u ? mine : 1u; nx = cnt > 0u ? cnt : 1u;
}
DI void xcd_barrier(const XcdBarrier& b) {
  asm volatile("s_waitcnt vmcnt(0)" ::: "memory");
  __syncthreads();
  if (threadIdx.x == 0) {
    unsigned* bar = b.bar;
    __builtin_amdgcn_s_waitcnt(0);
    unsigned nloc = b.st[0], nx = b.st[1];
    if (nloc == 0u) { xcd_barrier_complete(bar, b.x, nloc, nx); b.st[0] = nloc; b.st[1] = nx; }
    const unsigned old = xb_add(&bar[XB_XSUB(b.x)], 1u);
    const unsigned gen = old / nloc;
    if (old + 1u == (gen + 1u) * nloc) {
      __builtin_amdgcn_fence(__ATOMIC_RELEASE, "agent");
      asm volatile("s_waitcnt vmcnt(0)" ::: "memory");
      const unsigned og = xb_add(&bar[XB_TOP], 1u);
      const unsigned tg = og / nx;
      if (og + 1u == (tg + 1u) * nx) xb_add(&bar[XB_TOPGEN], 1u);
      else XB_SPIN(xb_ld(&bar[XB_TOPGEN]) == tg, bar);
      __builtin_amdgcn_fence(__ATOMIC_ACQUIRE, "agent");
      xb_add(&bar[XB_XGEN(b.x)], 1u);
      asm volatile("s_waitcnt vmcnt(0)" ::: "memory");
    } else {
      XB_SPIN(xb_ld(&bar[XB_XGEN(b.x)]) == gen, bar);
      __builtin_amdgcn_fence(__ATOMIC_ACQUIRE, "agent");
      asm volatile("s_waitcnt vmcnt(0)" ::: "memory");
    }
  }
  __syncthreads();
}

enum { PH_PREP = 0, PH_NORM1, PH_GEMM_IN, PH_FEAT, PH_MIX, PH_GDNOUT, PH_GEMM_BR, PH_GEMM_O, PH_NORM2, PH_FF1, PH_FF2, PH_COUNT };

__host__ __device__ inline int phase_count(int ph) {
  switch (ph) {
    case PH_PREP: return PREP_N;
    case PH_NORM1: return NORM1_N;
    case PH_GEMM_IN: return GEMM_IN_N;
    case PH_FEAT: return GDNA_N;
    case PH_MIX: return MIX_N;
    case PH_GDNOUT: return GDNOUT_N;
    case PH_GEMM_BR: return GEMM_BR_N;
    case PH_GEMM_O: return GEMM_FF2R_N;
    case PH_NORM2: return NORM_ROWS;
    case PH_FF1: return GEMM_FF1_N;
    case PH_FF2: return GEMM_FF2R_N;
  }
  return 0;
}

DI void run_item(CP P, int ph, int l, int item, char* smem) {
  switch (ph) {
    case PH_PREP: prep_item(P, item, smem); break;
    case PH_NORM1: if (item < NORM_ROWS) modnorm_item(P, l, 0, item); else cache_item(P, l, item - NORM_ROWS); break;
    case PH_GEMM_IN: gemm_in_item(P, l, item, smem); break;
    case PH_FEAT: gdn_a_item(P, l, item, smem); break;
    case PH_MIX: mix_item(P, l, item, smem); break;
    case PH_GDNOUT: gdnout_item(P, l, item); break;
    case PH_GEMM_BR: gemm_br_item(P, l, item, smem); break;
    case PH_GEMM_O: gemm_res_ring_item(P, l, item, smem, P->h, 1024, P->wt_o + (size_t)l * 1024 * 1024, 2048); break;
    case PH_NORM2: modnorm_item(P, l, 1, item); break;
    case PH_FF1: gemm_ff1_item(P, l, item, smem); break;
    case PH_FF2: gemm_res_ring_item(P, l, item, smem, P->f, 4096, P->wt_ff2 + (size_t)l * 1024 * 4096, 5120); break;
  }
}

#if !MEGA
template <int PH>
__global__ void __launch_bounds__(256, 2) k_phase(Params Pk, int l) {
  __shared__ __attribute__((aligned(16))) char smem[SMEM_BYTES];
  CP P = launder_params();
  const int n = phase_count(PH);
  for (int item = blockIdx.x; item < n; item += gridDim.x) run_item(P, PH, l, item, smem);
}
#else
template <int PH>
DI void phase_loop(int l, char* smem) {
  CP P = launder_params();
  const int n = phase_count(PH);
#pragma unroll 1
  for (int item = blockIdx.x; item < n; item += gridDim.x) run_item(P, PH, l, item, smem);
}

#ifndef PROBE_PH
#define PROBE_PH -1
#endif
#define GSYNC() xcd_barrier(xb)
#define RUNPH(PH_) do { phase_loop<PH_>(l, smem); GSYNC(); if (PROBE_PH == PH_) { phase_loop<PH_>(l, smem); GSYNC(); } } while (0)

DI void mix_loop(int l, unsigned* ctr, char* smem, int* s_item) {
  CP P = launder_params();
#pragma unroll 1
  for (;;) {
    __syncthreads();
    if (threadIdx.x == 0) *s_item = (int)atomicAdd(ctr, 1u);
    __syncthreads();
    const int item = *s_item;
    if (item >= MIX_N) break;
    run_item(P, PH_MIX, l, item, smem);
  }
}

__global__ void __launch_bounds__(256, 2) k_mega(Params Pk) {
  __shared__ __attribute__((aligned(16))) char smem[SMEM_BYTES];
  __shared__ uint4 xb_words;
  __shared__ int s_item;
  cg::grid_group grid = cg::this_grid();
  if (threadIdx.x == 0) xb_words = make_uint4(0u, 0u, 0u, 0u);
  __syncthreads();
  const XcdBarrier xb = xcd_barrier_post(launder_params()->bar, (volatile LAS unsigned*)&xb_words);
  phase_loop<PH_PREP>(0, smem);
  if (launder_params()->never) grid.sync();
  GSYNC();
  if (PROBE_PH == PH_PREP) { phase_loop<PH_PREP>(0, smem); GSYNC(); }
#pragma unroll 1
  for (int l = 0; l < 4; l++) {
    RUNPH(PH_NORM1);
    RUNPH(PH_GEMM_IN);
    RUNPH(PH_FEAT);
    mix_loop(l, launder_params()->counters + l, smem, &s_item);
    GSYNC();
    if (PROBE_PH == PH_MIX) { mix_loop(l, launder_params()->counters + 8 + l, smem, &s_item); GSYNC(); }
    RUNPH(PH_GDNOUT);
    RUNPH(PH_GEMM_BR);
    phase_loop<PH_GEMM_O>(l, smem); GSYNC();
    RUNPH(PH_NORM2);
    RUNPH(PH_FF1);
    phase_loop<PH_FF2>(l, smem); GSYNC();
  }
}
#endif

static inline size_t align_up(size_t x) { return (x + 255) & ~(size_t)255; }

extern "C" void kernel_launch(void* const* d_in, const int* in_sizes, int n_in, void* d_out, int out_size, void* d_ws, size_t ws_size, hipStream_t stream) {
  Params P;
  memset(&P, 0, sizeof(P));
  P.x_prompt = (const float*)d_in[0]; P.x_sample = (const float*)d_in[1];
  P.ckg = (const float*)d_in[2]; P.cvg = (const float*)d_in[3]; P.ckw = (const float*)d_in[4]; P.cvw = (const float*)d_in[5];
  P.state = (const float*)d_in[6]; P.c = (const float*)d_in[7]; P.c_ctx = (const float*)d_in[8];
  P.w_mod = (const float*)d_in[9]; P.b_mod = (const float*)d_in[10]; P.ln1 = (const float*)d_in[11]; P.ln2 = (const float*)d_in[12];
  P.w_in = (const float*)d_in[13]; P.conv = (const float*)d_in[14]; P.a_log = (const float*)d_in[15]; P.dt_bias = (const float*)d_in[16];
  P.a_norm = (const float*)d_in[17]; P.qk_norm = (const float*)d_in[18]; P.sink = (const float*)d_in[19];
  P.w_br_a = (const float*)d_in[20]; P.w_br_b = (const float*)d_in[21]; P.w_br_c = (const float*)d_in[22];
  P.w_o = (const float*)d_in[23]; P.w_ff1 = (const float*)d_in[24]; P.w_ff2 = (const float*)d_in[25];
  P.out = (float*)d_out;
  char* ws = (char*)d_ws;
  size_t off = 0;
  auto take = [&](size_t bytes) { char* p = ws + off; off = align_up(off + bytes); return p; };
  P.wt_in = (bf16_t*)take((size_t)4 * NCOLP * 1024 * 2);
  P.wt_br = (bf16_t*)take((size_t)4 * 3 * 1024 * 512 * 2);
  P.wt_o = (bf16_t*)take((size_t)4 * 1024 * 1024 * 2);
  P.wt_ff1 = (bf16_t*)take((size_t)4 * 4096 * 1024 * 2);
  P.wt_ff2 = (bf16_t*)take((size_t)4 * 4096 * 1024 * 2);
  P.mods = (float*)take((size_t)4 * 3 * 6144 * 4);
  P.ropec = (float*)take((size_t)4096 * 32 * 4);
  P.ropes = (float*)take((size_t)4096 * 32 * 4);
  P.counters = (unsigned*)take(1024);
  P.bar = (unsigned*)take((size_t)XCD_BAR_WORDS * 4);
  P.h = (bf16_t*)take((size_t)NTOK * DM * 2);
  P.kfB = (bf16_t*)take((size_t)4 * LFULL * 64 * 2);
  P.vtfB = (bf16_t*)take((size_t)4 * LFULL * 64 * 2);
  P.kfC = (bf16_t*)take((size_t)4 * LFULL * 64 * 2);
  P.vtfC = (bf16_t*)take((size_t)4 * LFULL * 64 * 2);
  P.kcB = (bf16_t*)take((size_t)32 * 256 * 64 * 2);
  P.vtcB = (bf16_t*)take((size_t)32 * 256 * 64 * 2);
  P.kcC = (bf16_t*)take((size_t)32 * 256 * 64 * 2);
  P.vtcC = (bf16_t*)take((size_t)32 * 256 * 64 * 2);
  P.ba = (float*)take((size_t)NTOK * 32 * 4);
  P.bg = (float*)take((size_t)NTOK * 32 * 4);
  P.yb = (bf16_t*)take((size_t)NTOK * 512 * 2);
  P.yc = (bf16_t*)take((size_t)NTOK * 512 * 2);
  P.qC = (bf16_t*)take((size_t)NTOK * 512 * 2);
  char* fregion = take((size_t)NTOK * DFF * 2);
  P.f = (bf16_t*)fregion;
  P.gates = (bf16_t*)fregion;
  P.z = (bf16_t*)(fregion + (size_t)NTOK * 3072 * 2);
  P.qB = (bf16_t*)(fregion + (size_t)NTOK * 3072 * 2 + (size_t)NTOK * 512 * 2);
  P.gq = (bf16_t*)take((size_t)NTOK * 512 * 2);
  P.gkT = (bf16_t*)take((size_t)NTOK * 512 * 2);
  P.gw = (bf16_t*)take((size_t)2 * NTOK * 512 * 2);
  P.gu = (bf16_t*)take((size_t)2 * NTOK * 512 * 2);
  P.gattn = P.h;
  P.geg = (float*)take((size_t)2 * NTOK * 8 * 4);
  P.gks = (float*)take((size_t)2 * NTOK * 8 * 4);
  P.ggl = (float*)take((size_t)2 * 1536 * 4);
  P.ya = P.gq;
  char* oregion = take((size_t)NTOK * 1536 * 2);
  P.obf = (bf16_t*)oregion;
  P.qkv_raw = (bf16_t*)oregion;
  if (off > ws_size) { fprintf(stderr, "workspace too small: need %zu have %zu\n", off, ws_size); return; }

#if !MEGA
#define LAUNCH(PH, l) hipLaunchKernelGGL(k_phase<PH>, dim3(phase_count(PH) < 8192 ? phase_count(PH) : 8192), dim3(256), 0, stream, P, l)
  LAUNCH(PH_PREP, 0);
  for (int l = 0; l < 4; l++) {
    LAUNCH(PH_NORM1, l); LAUNCH(PH_GEMM_IN, l); LAUNCH(PH_FEAT, l); LAUNCH(PH_MIX, l); LAUNCH(PH_GDNOUT, l);
    LAUNCH(PH_GEMM_BR, l); LAUNCH(PH_GEMM_O, l); LAUNCH(PH_NORM2, l); LAUNCH(PH_FF1, l); LAUNCH(PH_FF2, l);
  }
#else
  static int grid_blocks = 0;
  if (!grid_blocks) {
    int dev = 0, cus = 0, per_cu = 0;
    hipGetDevice(&dev);
    hipDeviceGetAttribute(&cus, hipDeviceAttributeMultiprocessorCount, dev);
    hipOccupancyMaxActiveBlocksPerMultiprocessor(&per_cu, k_mega, 256, 0);
    if (per_cu > 2) per_cu = 2;
    grid_blocks = cus * per_cu;
  }
  hipMemsetAsync(P.bar, 0, (size_t)XCD_BAR_WORDS * 4, stream);
  void* args[] = {&P};
  hipError_t e = hipLaunchCooperativeKernel((void*)k_mega, dim3(grid_blocks), dim3(256), args, 0, stream);
  if (e != hipSuccess) fprintf(stderr, "cooperative launch failed: %s (grid %d)\n", hipGetErrorString(e), grid_blocks);
#endif
}
```

```cpp
#include <hip/hip_runtime.h>
#include <hip/hip_cooperative_groups.h>
#include <stdint.h>
#include <stdio.h>
#include <string.h>
namespace cg = cooperative_groups;

#ifndef MEGA
#define MEGA 1
#endif

typedef unsigned short bf16_t;
typedef __attribute__((ext_vector_type(8))) short bf16x8;
typedef __attribute__((ext_vector_type(4))) short bf16x4;
typedef __attribute__((ext_vector_type(4))) float f32x4;
#define DI __device__ __forceinline__
#define MFMA16(a, b, c) __builtin_amdgcn_mfma_f32_16x16x32_bf16((a), (b), (c), 0, 0, 0)

constexpr int NTOK = 12288, NCTX = 4096, DM = 1024, NCOLP = 6784, INCOLS = 6688, DFF = 4096;
constexpr int LFULL = 4608;
constexpr float EPS = 1e-6f;
constexpr float LOG2E = 1.4426950408889634f;
constexpr float QSCALE = 0.125f * LOG2E;
constexpr size_t OUT_KG = 12582912, OUT_VG = 14680064, OUT_KW = 16777216, OUT_VW = 18874368, OUT_ST = 20971520;
constexpr int SMEM_BYTES = 73728;

struct Params {
  const float *x_prompt, *x_sample, *ckg, *cvg, *ckw, *cvw, *state, *c, *c_ctx, *w_mod, *b_mod, *ln1, *ln2, *w_in, *conv,
      *a_log, *dt_bias, *a_norm, *qk_norm, *sink, *w_br_a, *w_br_b, *w_br_c, *w_o, *w_ff1, *w_ff2;
  float* out;
  bf16_t *wt_in, *wt_br, *wt_o, *wt_ff1, *wt_ff2;
  float *mods, *ropec, *ropes;
  unsigned* counters;
  unsigned* bar;
  long long never;
  bf16_t* h;
  bf16_t *qkv_raw, *z, *qB, *qC, *gates;
  float *ba, *bg;
  bf16_t *gq, *gkT, *gw, *gu, *gattn, *obf;
  float *geg, *gks, *ggl;
  bf16_t *kfB, *vtfB, *kfC, *vtfC;
  bf16_t *kcB, *vtcB, *kcC, *vtcC;
  bf16_t *ya, *yb, *yc;
  bf16_t* f;
};

typedef const __attribute__((address_space(4))) Params* CP;

DI CP launder_params() {
  CP cp = (CP)__builtin_amdgcn_kernarg_segment_ptr();
  asm volatile("" : "+s"(cp));
  return cp;
}

DI float bf2f(bf16_t x) { return __uint_as_float(((unsigned)x) << 16); }
DI unsigned pack2(float a, float b) { unsigned r; asm("v_cvt_pk_bf16_f32 %0, %1, %2" : "=v"(r) : "v"(a), "v"(b)); return r; }
DI bf16_t f2bf(float f) { unsigned u = __float_as_uint(f); u += 0x7fffu + ((u >> 16) & 1u); return (bf16_t)(u >> 16); }
typedef __attribute__((ext_vector_type(4))) unsigned u32x4_t;
DI bf16x8 pack8(float x0, float x1, float x2, float x3, float x4, float x5, float x6, float x7) {
  u32x4_t p;
  asm volatile("v_cvt_pk_bf16_f32 %0, %4, %5\n\tv_cvt_pk_bf16_f32 %1, %6, %7\n\tv_cvt_pk_bf16_f32 %2, %8, %9\n\tv_cvt_pk_bf16_f32 %3, %10, %11\n\ts_nop 1"
               : "=&v"(p[0]), "=&v"(p[1]), "=&v"(p[2]), "=&v"(p[3])
               : "v"(x0), "v"(x1), "v"(x2), "v"(x3), "v"(x4), "v"(x5), "v"(x6), "v"(x7));
  return __builtin_bit_cast(bf16x8, p);
}
DI int tidx() { int t = threadIdx.x; asm volatile("" : "+v"(t)); return t; }
DI float wave_sum(float v) {
#pragma unroll
  for (int o = 32; o > 0; o >>= 1) v += __shfl_xor(v, o);
  return v;
}
DI float sigmoidf_(float x) { return 1.f / (1.f + __expf(-x)); }
DI float siluf_(float x) { return x / (1.f + __expf(-x)); }
DI int mod_index(int n) { return n < NCTX ? 0 : 1 + ((n - NCTX) >> 12); }

constexpr int PREP_MODS = 384, PREP_TRL = 4384, PREP_TR = 4 * PREP_TRL, PREP_XC = 768, PREP_ROPE = 32, PREP_MISC = 1;
constexpr int PREP_N = PREP_MODS + PREP_TR + PREP_XC + PREP_ROPE + PREP_MISC;

DI void tr_tile(const float* __restrict__ src, int ldsrc, int srccol0, int nvalid, bf16_t* __restrict__ dst, int ldd, int n0, int k0, float* tile) {
  const int tid = tidx();
  {
    const int nn4 = (tid & 15) * 4;
#pragma unroll
    for (int i = 0; i < 4; i++) {
      const int kk = (tid >> 4) + 16 * i;
      float4 v = make_float4(0.f, 0.f, 0.f, 0.f);
      if (nn4 < nvalid) v = *(const float4*)(src + (size_t)(k0 + kk) * ldsrc + srccol0 + nn4);
      tile[kk * 65 + nn4 + 0] = v.x; tile[kk * 65 + nn4 + 1] = v.y; tile[kk * 65 + nn4 + 2] = v.z; tile[kk * 65 + nn4 + 3] = v.w;
    }
  }
  __syncthreads();
  {
    const int kk4 = (tid & 15) * 4;
#pragma unroll
    for (int i = 0; i < 4; i++) {
      const int nn = (tid >> 4) + 16 * i;
      uint2 o;
      o.x = pack2(tile[(kk4 + 0) * 65 + nn], tile[(kk4 + 1) * 65 + nn]);
      o.y = pack2(tile[(kk4 + 2) * 65 + nn], tile[(kk4 + 3) * 65 + nn]);
      *(uint2*)(dst + (size_t)(n0 + nn) * ldd + k0 + kk4) = o;
    }
  }
  __syncthreads();
}

DI void prep_item(CP P, int item, char* smem) {
  const int tid = tidx(), lane = tid & 63, wid = tid >> 6;
  float* sm = (float*)smem;
  if (item < PREP_MODS) {
    const int l = item / 96, jb = item % 96;
    float* ssil = sm;
    float* red = sm + 3072;
    for (int k = tid; k < 1024; k += 256) {
      ssil[k] = siluf_(P->c_ctx[k]);
      ssil[1024 + k] = siluf_(P->c[k]);
      ssil[2048 + k] = siluf_(P->c[1024 + k]);
    }
    __syncthreads();
    const float* W = P->w_mod + (size_t)l * 1024 * 6144 + jb * 64 + lane;
    float a0 = 0.f, a1 = 0.f, a2 = 0.f;
    const int kb = wid * 256;
#pragma unroll 8
    for (int k = 0; k < 256; k++) {
      const float w = W[(size_t)(kb + k) * 6144];
      a0 += ssil[kb + k] * w; a1 += ssil[1024 + kb + k] * w; a2 += ssil[2048 + kb + k] * w;
    }
    red[(wid * 3 + 0) * 64 + lane] = a0; red[(wid * 3 + 1) * 64 + lane] = a1; red[(wid * 3 + 2) * 64 + lane] = a2;
    __syncthreads();
    if (tid < 192) {
      const int m = tid >> 6, jj = tid & 63;
      float s = 0.f;
      for (int w = 0; w < 4; w++) s += red[(w * 3 + m) * 64 + jj];
      P->mods[((size_t)l * 3 + m) * 6144 + jb * 64 + jj] = s + P->b_mod[(size_t)l * 6144 + jb * 64 + jj];
    }
    __syncthreads();
    return;
  }
  item -= PREP_MODS;
  if (item < PREP_TR) {
    const int l = item / PREP_TRL; int s = item % PREP_TRL;
    if (s < 1696) {
      const int nt = s / 16, kt = s % 16;
      int srccol0 = nt * 64, nvalid = 64;
      if (nt == 32) { srccol0 = 2048; nvalid = 32; } else if (nt > 32 && nt < 105) { srccol0 = nt * 64 - 32; } else if (nt >= 105) { nvalid = 0; srccol0 = 0; }
      tr_tile(P->w_in + (size_t)l * 1024 * INCOLS, INCOLS, srccol0, nvalid, P->wt_in + (size_t)l * NCOLP * 1024, 1024, nt * 64, kt * 64, sm);
      return;
    }
    s -= 1696;
    if (s < 384) {
      const int which = s / 128, r = s % 128, nt = r / 8, kt = r % 8;
      const float* src = (which == 0 ? P->w_br_a : which == 1 ? P->w_br_b : P->w_br_c) + (size_t)l * 512 * 1024;
      tr_tile(src, 1024, nt * 64, 64, P->wt_br + (size_t)(l * 3 + which) * 1024 * 512, 512, nt * 64, kt * 64, sm);
      return;
    }
    s -= 384;
    if (s < 256) {
      const int nt = s / 16, kt = s % 16;
      tr_tile(P->w_o + (size_t)l * 1024 * 1024, 1024, nt * 64, 64, P->wt_o + (size_t)l * 1024 * 1024, 1024, nt * 64, kt * 64, sm);
      return;
    }
    s -= 256;
    if (s < 1024) {
      const int nt = s / 16, kt = s % 16;
      tr_tile(P->w_ff1 + (size_t)l * 1024 * 4096, 4096, nt * 64, 64, P->wt_ff1 + (size_t)l * 4096 * 1024, 1024, nt * 64, kt * 64, sm);
      return;
    }
    s -= 1024;
    {
      const int nt = s / 64, kt = s % 64;
      tr_tile(P->w_ff2 + (size_t)l * 4096 * 1024, 1024, nt * 64, 64, P->wt_ff2 + (size_t)l * 1024 * 4096, 4096, nt * 64, kt * 64, sm);
      return;
    }
  }
  item -= PREP_TR;
  if (item < PREP_XC) {
    const size_t base = (size_t)item * 16384;
    const float4* src = (const float4*)(base < 4194304 ? P->x_prompt + base : P->x_sample + (base - 4194304));
    float4* dst = (float4*)(P->out + base);
#pragma unroll 4
    for (int i = 0; i < 16; i++) dst[tid + 256 * i] = src[tid + 256 * i];
    return;
  }
  item -= PREP_XC;
  if (item < PREP_ROPE) {
    for (int i = 0; i < 16; i++) {
      const int e = item * 4096 + tid + 256 * i;
      const int t = e >> 5, i2 = e & 31;
      const int pos = (i2 < 16) ? (t >> 6) : (t & 63);
      const int fi = i2 & 15;
      const float inv = exp2f(-(float)fi * (13.287712379549449f / 16.f));
      const float ang = (float)pos * inv;
      P->ropec[e] = cosf(ang);
      P->ropes[e] = sinf(ang);
    }
    return;
  }
  item -= PREP_ROPE;
  if (tid < 64) P->counters[tid] = 0u;
}

constexpr int NORM_ROWS = NTOK / 8;
constexpr int NORM1_N = NORM_ROWS + 512;

DI void modnorm_item(CP P, int l, int which, int item) {
  const int tid = tidx(), lane = tid & 63, wid = tid >> 6;
  const int nb = item * 8 + wid * 2;
  float4 v[2][4];
  float ss[2];
#pragma unroll
  for (int r = 0; r < 2; r++) {
    const float* xr = P->out + (size_t)(nb + r) * DM;
#pragma unroll
    for (int i = 0; i < 4; i++) v[r][i] = *(const float4*)(xr + lane * 4 + 256 * i);
  }
  const float* md = P->mods + ((size_t)l * 3 + mod_index(nb)) * 6144;
  const float* sh = md + (which ? 3072 : 0);
  const float* sc = md + (which ? 4096 : 1024);
  const float* lw = (which ? P->ln2 : P->ln1) + (size_t)l * DM;
  float4 w4[4], s4[4], h4[4];
#pragma unroll
  for (int i = 0; i < 4; i++) {
    const int c = lane * 4 + 256 * i;
    w4[i] = *(const float4*)(lw + c); s4[i] = *(const float4*)(sc + c); h4[i] = *(const float4*)(sh + c);
    w4[i].x *= 1.f + s4[i].x; w4[i].y *= 1.f + s4[i].y; w4[i].z *= 1.f + s4[i].z; w4[i].w *= 1.f + s4[i].w;
  }
#pragma unroll
  for (int r = 0; r < 2; r++) {
    float a = 0.f;
#pragma unroll
    for (int i = 0; i < 4; i++) a += v[r][i].x * v[r][i].x + v[r][i].y * v[r][i].y + v[r][i].z * v[r][i].z + v[r][i].w * v[r][i].w;
    ss[r] = wave_sum(a);
  }
#pragma unroll
  for (int r = 0; r < 2; r++) {
    const float rstd = rsqrtf(ss[r] * (1.f / 1024.f) + EPS);
#pragma unroll
    for (int i = 0; i < 4; i++) {
      const int c = lane * 4 + 256 * i;
      uint2 o;
      o.x = pack2(v[r][i].x * rstd * w4[i].x + h4[i].x, v[r][i].y * rstd * w4[i].y + h4[i].y);
      o.y = pack2(v[r][i].z * rstd * w4[i].z + h4[i].z, v[r][i].w * rstd * w4[i].w + h4[i].w);
      *(uint2*)(P->h + (size_t)(nb + r) * DM + c) = o;
    }
  }
}

DI void cache_item(CP P, int l, int item) {
  const int tid = tidx();
  const int type = item >> 8, b = (item >> 7) & 1, pg = item & 127;
  const float* ck = type ? P->ckw : P->ckg;
  const float* cv = type ? P->cvw : P->cvg;
  bf16_t* kf = type ? P->kfC : P->kfB;
  bf16_t* vtf = type ? P->vtfC : P->vtfB;
#pragma unroll
  for (int i = 0; i < 2; i++) {
    const int e = tid + 256 * i;
    const int pl = e >> 7, c = e & 127, kvh = c >> 6, d = c & 63;
    const int pos = pg * 4 + pl;
    const size_t si = ((((size_t)b * 4 + l) * 512 + pos) * 2 + kvh) * 64 + d;
    kf[((size_t)(b * 2 + kvh) * LFULL + pos) * 64 + d] = f2bf(ck[si]);
    vtf[((size_t)(b * 2 + kvh) * 64 + d) * LFULL + pos] = f2bf(cv[si]);
  }
}

DI int lds_byte(int r, int c) { const int st = (r >> 4) * 2 + (c >> 5), rr = r & 15, cc = c & 31, ob = rr * 64 + cc * 2; return st * 1024 + (ob ^ (((ob >> 9) & 1) << 5)); }
DI void stage_rc(int b, int& R, int& C) { const int st = b >> 10, sb = b & 1023, swz = sb ^ (((sb >> 9) & 1) << 5); R = (st >> 1) * 16 + (swz >> 6); C = (st & 1) * 32 + ((swz & 63) >> 1); }

template <int ROWS>
DI void stage_tile(const bf16_t* __restrict__ g, int ld, char* lds, int tid) {
#pragma unroll
  for (int i = 0; i < ROWS / 32; i++) {
    const int b = tid * 16 + i * 4096;
    int R, C;
    stage_rc(b, R, C);
    __builtin_amdgcn_global_load_lds((const unsigned*)(g + (size_t)R * ld + C), (unsigned*)(lds + b), 16, 0, 0);
  }
}

template <int NI>
DI void gemm_mainloop(const bf16_t* __restrict__ A, int lda, const bf16_t* __restrict__ Bt, int ldb, int K, int m0, int n0, bf16_t* smb, f32x4 (&acc)[4][NI]) {
  char* sm = (char*)smb;
  const int tid = tidx(), lane = tid & 63, wid = tid >> 6, wm = wid >> 1, wn = wid & 1, lr = lane & 15, quad = lane >> 4;
  const bf16_t* ga = A + (size_t)m0 * lda;
  const bf16_t* gb = Bt + (size_t)n0 * ldb;
  int offA[4][2], offB[NI][2];
#pragma unroll
  for (int ks = 0; ks < 2; ks++) {
#pragma unroll
    for (int mi = 0; mi < 4; mi++) offA[mi][ks] = lds_byte(wm * 64 + mi * 16 + lr, ks * 32 + quad * 8);
#pragma unroll
    for (int ni = 0; ni < NI; ni++) offB[ni][ks] = 16384 + lds_byte(wn * 16 * NI + ni * 16 + lr, ks * 32 + quad * 8);
  }
  __syncthreads();
  stage_tile<128>(ga, lda, sm, tid);
  stage_tile<32 * NI>(gb, ldb, sm + 16384, tid);
  asm volatile("s_waitcnt vmcnt(0)" ::: "memory");
  __syncthreads();
  const int nk = K >> 6;
  for (int kt = 0; kt < nk; kt++) {
    const int cur = kt & 1;
    if (kt + 1 < nk) {
      char* nb = sm + (cur ^ 1) * 32768;
      stage_tile<128>(ga + (kt + 1) * 64, lda, nb, tid);
      stage_tile<32 * NI>(gb + (kt + 1) * 64, ldb, nb + 16384, tid);
    }
    const char* cb = sm + cur * 32768;
#pragma unroll
    for (int ks = 0; ks < 2; ks++) {
      bf16x8 af[4], bfr[NI];
#pragma unroll
      for (int mi = 0; mi < 4; mi++) af[mi] = *(const bf16x8*)(cb + offA[mi][ks]);
#pragma unroll
      for (int ni = 0; ni < NI; ni++) bfr[ni] = *(const bf16x8*)(cb + offB[ni][ks]);
#pragma unroll
      for (int mi = 0; mi < 4; mi++)
#pragma unroll
        for (int ni = 0; ni < NI; ni++) acc[mi][ni] = MFMA16(af[mi], bfr[ni], acc[mi][ni]);
    }
    asm volatile("s_waitcnt vmcnt(0)" ::: "memory");
    __syncthreads();
  }
}

template <int MI, int NI>
DI void gemm_mainloop3(const bf16_t* __restrict__ A, int lda, const bf16_t* __restrict__ Bt, int ldb, int K, int m0, int n0, char* sm, f32x4 (&acc)[MI][NI]) {
  constexpr int A_BYTES = 32 * MI * 64, B_BYTES = 32 * NI * 64, STAGE = A_BYTES + B_BYTES;
  static_assert(3 * STAGE <= SMEM_BYTES, "LDS");
  const int tid = tidx(), lane = tid & 63, wid = tid >> 6, wm = wid >> 1, wn = wid & 1, lr = lane & 15, quad = lane >> 4;
  const int sb = (tid * 16) & 1023, swz = sb ^ (((sb >> 9) & 1) << 5), rr = swz >> 6, cc = (swz & 63) >> 1;
  const bf16_t* ga = A + (size_t)(m0 + wid * 16 + rr) * lda + cc;
  const bf16_t* gb = Bt + (size_t)(n0 + wid * 16 + rr) * ldb + cc;
  const int lane_off = (lr * 64 + quad * 16) ^ (((lr >> 3) & 1) << 5);
  const int offA = (wm * MI) * 1024 + lane_off, offB = A_BYTES + (wn * NI) * 1024 + lane_off;
#define G3_STAGE(buf_, kt_) do { char* d_ = sm + (buf_) * STAGE + tid * 16; const int ko_ = (kt_) * 32; \
    _Pragma("unroll") for (int i = 0; i < MI / 2; i++) __builtin_amdgcn_global_load_lds((const unsigned*)(ga + (size_t)(i * 64) * lda + ko_), (unsigned*)(d_ + i * 4096), 16, 0, 0); \
    _Pragma("unroll") for (int i = 0; i < NI / 2; i++) __builtin_amdgcn_global_load_lds((const unsigned*)(gb + (size_t)(i * 64) * ldb + ko_), (unsigned*)(d_ + A_BYTES + i * 4096), 16, 0, 0); \
  } while (0)
  const int nk = K >> 5;
  __syncthreads();
  G3_STAGE(0, 0);
  G3_STAGE(1, 1);
  int cur = 0;
  for (int kt = 0; kt < nk; kt++) {
    if (kt + 1 < nk) asm volatile("s_waitcnt vmcnt(%0)" ::"n"(MI / 2 + NI / 2) : "memory");
    else asm volatile("s_waitcnt vmcnt(0)" ::: "memory");
    __builtin_amdgcn_s_barrier();
    asm volatile("" ::: "memory");
    const char* cb = sm + cur * STAGE;
    bf16x8 af[MI], bfr[NI];
#pragma unroll
    for (int mi = 0; mi < MI; mi++) af[mi] = *(const bf16x8*)(cb + offA + mi * 1024);
#pragma unroll
    for (int ni = 0; ni < NI; ni++) bfr[ni] = *(const bf16x8*)(cb + offB + ni * 1024);
    if (kt + 2 < nk) { const int nb = cur >= 1 ? cur - 1 : 2; G3_STAGE(nb, kt + 2); }
#pragma unroll
    for (int mi = 0; mi < MI; mi++)
#pragma unroll
      for (int ni = 0; ni < NI; ni++) acc[mi][ni] = MFMA16(af[mi], bfr[ni], acc[mi][ni]);
    cur = cur == 2 ? 0 : cur + 1;
  }
#undef G3_STAGE
}

template <int MI, int NI>
DI void zero_acc2(f32x4 (&acc)[MI][NI]) {
#pragma unroll
  for (int i = 0; i < MI; i++)
#pragma unroll
    for (int j = 0; j < NI; j++) acc[i][j] = (f32x4){0.f, 0.f, 0.f, 0.f};
}

template <int NI>
DI void zero_acc(f32x4 (&acc)[4][NI]) {
#pragma unroll
  for (int i = 0; i < 4; i++)
#pragma unroll
    for (int j = 0; j < NI; j++) acc[i][j] = (f32x4){0.f, 0.f, 0.f, 0.f};
}

DI bool tile_map(int item, int MT, int NT, int& mt, int& nt) {
  const int r = item >> 9, within = item & 511, x = within & 7, q = within >> 3;
  const int patch = r * 8 + x, pmn = MT >> 3;
  mt = (patch % pmn) * 8 + (q & 7);
  nt = (patch / pmn) * 8 + (q >> 3);
  return nt < NT;
}

constexpr int GEMM_IN_N = 48 * 53;

DI void gemm_in_item(CP P, int l, int item, char* smem) {
  const int mt = item % 48, nt = item / 48;
  const int m0 = mt * 256, n0 = nt * 128;
  f32x4 acc[8][4];
  zero_acc2<8, 4>(acc);
  gemm_mainloop3<8, 4>(P->h, DM, P->wt_in + (size_t)l * NCOLP * 1024, 1024, 1024, m0, n0, smem, acc);
  const int tid = tidx(), lane = tid & 63, wid = tid >> 6, wm = wid >> 1, wn = wid & 1, lr = lane & 15, quad = lane >> 4;
  const int row0 = m0 + wm * 128, col0 = n0 + wn * 64;
  const int w64 = col0 >> 6;
  if (w64 < 24) {
#pragma unroll
    for (int mi = 0; mi < 8; mi++)
#pragma unroll
      for (int j = 0; j < 4; j++) {
        const size_t row = row0 + mi * 16 + quad * 4 + j;
#pragma unroll
        for (int ni = 0; ni < 4; ni++) P->qkv_raw[row * 1536 + w64 * 64 + ni * 16 + lr] = f2bf(acc[mi][ni][j]);
      }
  } else if (w64 < 32) {
#pragma unroll
    for (int mi = 0; mi < 8; mi++)
#pragma unroll
      for (int j = 0; j < 4; j++) {
        const size_t row = row0 + mi * 16 + quad * 4 + j;
#pragma unroll
        for (int ni = 0; ni < 4; ni++) P->z[row * 512 + (w64 - 24) * 64 + ni * 16 + lr] = f2bf(acc[mi][ni][j]);
      }
  } else if (w64 == 32) {
#pragma unroll
    for (int mi = 0; mi < 8; mi++)
#pragma unroll
      for (int j = 0; j < 4; j++) {
        const size_t row = row0 + mi * 16 + quad * 4 + j;
#pragma unroll
        for (int ni = 0; ni < 2; ni++) P->ba[row * 32 + ni * 16 + lr] = acc[mi][ni][j];
      }
  } else if (w64 < 57) {
    const int hidx = w64 - 33;
    const int typeC = hidx >= 12;
    const int hh = typeC ? hidx - 12 : hidx;
    const bool isq = hh < 8, isk = (hh == 8 || hh == 9), isv = hh >= 10;
    const int kvh = isk ? hh - 8 : (isv ? hh - 10 : 0);
    const bool latent = row0 >= NCTX;
    const float* qn = P->qk_norm + ((size_t)l * 4 + (typeC ? 2 : 0) + (isk ? 1 : 0)) * 64;
    float qw[4];
#pragma unroll
    for (int ni = 0; ni < 4; ni++) qw[ni] = qn[ni * 16 + lr];
#pragma unroll
    for (int mi = 0; mi < 8; mi++)
#pragma unroll
      for (int j = 0; j < 4; j++) {
        const int row = row0 + mi * 16 + quad * 4 + j;
        float val[4];
#pragma unroll
        for (int ni = 0; ni < 4; ni++) val[ni] = acc[mi][ni][j];
        if (!isv) {
          float ss = val[0] * val[0] + val[1] * val[1] + val[2] * val[2] + val[3] * val[3];
          ss += __shfl_xor(ss, 1); ss += __shfl_xor(ss, 2); ss += __shfl_xor(ss, 4); ss += __shfl_xor(ss, 8);
          const float rstd = rsqrtf(ss * (1.f / 64.f) + EPS);
#pragma unroll
          for (int ni = 0; ni < 4; ni++) val[ni] = val[ni] * rstd * qw[ni];
        }
        if (!latent) {
          const int b = row >> 8, t = row & 255;
          if (isq) {
            bf16_t* q = (typeC ? P->qC : P->qB) + (size_t)row * 512 + hh * 64;
#pragma unroll
            for (int ni = 0; ni < 4; ni++) q[ni * 16 + lr] = f2bf(val[ni] * QSCALE);
          } else if (isk) {
            bf16_t* kc = (typeC ? P->kcC : P->kcB) + ((size_t)(b * 2 + kvh) * 256 + t) * 64;
            float* ko = P->out + (typeC ? OUT_KW : OUT_KG) + (((size_t)(b * 4 + l) * 256 + t) * 2 + kvh) * 64;
#pragma unroll
            for (int ni = 0; ni < 4; ni++) { kc[ni * 16 + lr] = f2bf(val[ni]); ko[ni * 16 + lr] = val[ni]; }
          } else {
            bf16_t* vt = (typeC ? P->vtcC : P->vtcB) + (size_t)(b * 2 + kvh) * 64 * 256 + t;
            float* vo = P->out + (typeC ? OUT_VW : OUT_VG) + (((size_t)(b * 4 + l) * 256 + t) * 2 + kvh) * 64;
#pragma unroll
            for (int ni = 0; ni < 4; ni++) { vt[(size_t)(ni * 16 + lr) * 256] = f2bf(val[ni]); vo[ni * 16 + lr] = val[ni]; }
          }
        } else {
          const int b = (row - NCTX) >> 12, t = (row - NCTX) & 4095;
          if (!isv) {
            const float c0 = P->ropec[t * 32 + lr], c1 = P->ropec[t * 32 + 16 + lr];
            const float s0 = P->ropes[t * 32 + lr], s1 = P->ropes[t * 32 + 16 + lr];
            const float x10 = val[0], x11 = val[1], x20 = val[2], x21 = val[3];
            val[0] = x10 * c0 - x20 * s0; val[2] = x20 * c0 + x10 * s0;
            val[1] = x11 * c1 - x21 * s1; val[3] = x21 * c1 + x11 * s1;
          }
          if (isq) {
            bf16_t* q = (typeC ? P->qC : P->qB) + (size_t)row * 512 + hh * 64;
#pragma unroll
            for (int ni = 0; ni < 4; ni++) q[ni * 16 + lr] = f2bf(val[ni] * QSCALE);
          } else if (isk) {
            bf16_t* kf = (typeC ? P->kfC : P->kfB) + ((size_t)(b * 2 + kvh) * LFULL + 512 + t) * 64;
#pragma unroll
            for (int ni = 0; ni < 4; ni++) kf[ni * 16 + lr] = f2bf(val[ni]);
          } else {
            bf16_t* vt = (typeC ? P->vtfC : P->vtfB) + (size_t)(b * 2 + kvh) * 64 * LFULL + 512 + t;
#pragma unroll
            for (int ni = 0; ni < 4; ni++) vt[(size_t)(ni * 16 + lr) * LFULL] = f2bf(val[ni]);
          }
        }
      }
  } else if (w64 < 105) {
#pragma unroll
    for (int mi = 0; mi < 8; mi++)
#pragma unroll
      for (int j = 0; j < 4; j++) {
        const size_t row = row0 + mi * 16 + quad * 4 + j;
#pragma unroll
        for (int ni = 0; ni < 4; ni++) P->gates[row * 3072 + (w64 - 57) * 64 + ni * 16 + lr] = f2bf(sigmoidf_(acc[mi][ni][j]));
      }
  }
}

constexpr int GEMM_D_N = 96 * 8;
constexpr int GEMM_BR_N = 96 * 16;

DI void gemm_br_item(CP P, int l, int item, char* smem) {
  const int mt = item % 96, nt = item / 96;
  const int m0 = mt * 128, n0 = nt * 64;
  const int tid = tidx(), lane = tid & 63, wid = tid >> 6, wm = wid >> 1, wn = wid & 1, lr = lane & 15, quad = lane >> 4;
  const int row0 = m0 + wm * 64, col0 = n0 + wn * 32;
  f32x4 tot[4][2];
  zero_acc<2>(tot);
#pragma unroll 1
  for (int br = 0; br < 3; br++) {
    f32x4 acc[4][2];
    zero_acc<2>(acc);
    const bf16_t* A = br == 0 ? P->ya : br == 1 ? P->yb : P->yc;
    gemm_mainloop<2>(A, 512, P->wt_br + (size_t)(l * 3 + br) * 1024 * 512, 512, 512, m0, n0, (bf16_t*)smem, acc);
#pragma unroll
    for (int mi = 0; mi < 4; mi++)
#pragma unroll
      for (int j = 0; j < 4; j++) {
        const size_t row = row0 + mi * 16 + quad * 4 + j;
#pragma unroll
        for (int ni = 0; ni < 2; ni++) tot[mi][ni][j] += bf2f(P->gates[row * 3072 + br * 1024 + col0 + ni * 16 + lr]) * acc[mi][ni][j];
      }
  }
#pragma unroll
  for (int mi = 0; mi < 4; mi++)
#pragma unroll
    for (int j = 0; j < 4; j++) {
      const size_t row = row0 + mi * 16 + quad * 4 + j;
#pragma unroll
      for (int ni = 0; ni < 2; ni++) P->h[row * DM + col0 + ni * 16 + lr] = f2bf(tot[mi][ni][j]);
    }
}

constexpr int GEMM_RES_N = 1024;
template <int NI>
DI void gemm_res_tile(CP P, int l, char* smem, const bf16_t* A, int K, const bf16_t* Bt, int gate_off, int m0, int n0) {
  f32x4 acc[4][NI];
  zero_acc<NI>(acc);
  gemm_mainloop<NI>(A, K, Bt, K, K, m0, n0, (bf16_t*)smem, acc);
  const int tid = tidx(), lane = tid & 63, wid = tid >> 6, wm = wid >> 1, wn = wid & 1, lr = lane & 15, quad = lane >> 4;
  const int row0 = m0 + wm * 64, col0 = n0 + wn * 16 * NI;
  const float* g = P->mods + ((size_t)l * 3 + mod_index(row0)) * 6144 + gate_off + col0;
  float gv[NI];
#pragma unroll
  for (int ni = 0; ni < NI; ni++) gv[ni] = g[ni * 16 + lr];
#pragma unroll
  for (int mi = 0; mi < 4; mi++)
#pragma unroll
    for (int j = 0; j < 4; j++) {
      const size_t row = row0 + mi * 16 + quad * 4 + j;
#pragma unroll
      for (int ni = 0; ni < NI; ni++) {
        float* xp = P->out + row * DM + col0 + ni * 16 + lr;
        *xp = *xp + gv[ni] * acc[mi][ni][j];
      }
    }
}
DI void gemm_res_item(CP P, int l, int item, char* smem, const bf16_t* A, int K, const bf16_t* Bt, int gate_off) {
  if (item < 512) {
    gemm_res_tile<4>(P, l, smem, A, K, Bt, gate_off, (item % 96) * 128, (item / 96) * 128);
  } else {
    const int hi = item - 512, tile = 512 + (hi >> 1);
    gemm_res_tile<2>(P, l, smem, A, K, Bt, gate_off, (tile % 96) * 128, (tile / 96) * 128 + (hi & 1) * 64);
  }
}

constexpr int GEMM_FF2R_N = 64 * 8;
DI void gemm_ff2_ring_item(CP P, int l, int item, char* smem) {
  const int mt = item % 64, nt = item / 64;
  const int m0 = mt * 192, n0 = nt * 128;
  f32x4 acc[6][4];
  zero_acc2<6, 4>(acc);
  gemm_mainloop3<6, 4>(P->f, DFF, P->wt_ff2 + (size_t)l * 1024 * 4096, DFF, DFF, m0, n0, smem, acc);
  const int tid = tidx(), lane = tid & 63, wid = tid >> 6, wm = wid >> 1, wn = wid & 1, lr = lane & 15, quad = lane >> 4;
  const int row0 = m0 + wm * 96, col0 = n0 + wn * 64;
#pragma unroll
  for (int mi = 0; mi < 6; mi++) {
    const float* g = P->mods + ((size_t)l * 3 + mod_index(row0 + mi * 16)) * 6144 + 5120 + col0;
    float gv[4];
#pragma unroll
    for (int ni = 0; ni < 4; ni++) gv[ni] = g[ni * 16 + lr];
#pragma unroll
    for (int j = 0; j < 4; j++) {
      const size_t row = row0 + mi * 16 + quad * 4 + j;
#pragma unroll
      for (int ni = 0; ni < 4; ni++) {
        float* xp = P->out + row * DM + col0 + ni * 16 + lr;
        *xp = *xp + gv[ni] * acc[mi][ni][j];
      }
    }
  }
}

constexpr int GEMM_FF1_N = 48 * 32;
DI void gemm_ff1_item(CP P, int l, int item, char* smem) {
  int mt, nt;
  tile_map(item, 48, 32, mt, nt);
  const int m0 = mt * 256, n0 = nt * 128;
  f32x4 acc[8][4];
  zero_acc2<8, 4>(acc);
  gemm_mainloop3<8, 4>(P->h, DM, P->wt_ff1 + (size_t)l * DFF * 1024, 1024, 1024, m0, n0, smem, acc);
  const int tid = tidx(), lane = tid & 63, wid = tid >> 6, wm = wid >> 1, wn = wid & 1, lr = lane & 15, quad = lane >> 4;
  const int row0 = m0 + wm * 128, col0 = n0 + wn * 64;
#pragma unroll
  for (int mi = 0; mi < 8; mi++)
#pragma unroll
    for (int j = 0; j < 4; j++) {
      const size_t row = row0 + mi * 16 + quad * 4 + j;
#pragma unroll
      for (int ni = 0; ni < 4; ni++) {
        const float r = fmaxf(acc[mi][ni][j], 0.f);
        P->f[row * DFF + col0 + ni * 16 + lr] = f2bf(r * r);
      }
    }
}

#define MFMA16K16(a, b, c) __builtin_amdgcn_mfma_f32_16x16x16bf16_1k((a), (b), (c), 0, 0, 0)
DI unsigned bf16_sw(float f) { unsigned u = __float_as_uint(f); u += 0x7fffu + ((u >> 16) & 1u); return u >> 16; }
DI bf16x4 pack4(float x0, float x1, float x2, float x3) {
  typedef __attribute__((ext_vector_type(2))) unsigned u32x2_t;
  u32x2_t t;
  t[0] = bf16_sw(x0) | (bf16_sw(x1) << 16);
  t[1] = bf16_sw(x2) | (bf16_sw(x3) << 16);
  return __builtin_bit_cast(bf16x4, t);
}

DI void gdn_dinv(const float* M, float* Dv, int tid) {
  const int dir = tid >> 6, blk = (tid >> 4) & 3, c = tid & 15;
  const float* Mb = M + (blk * 16) * 64 + blk * 16;
  float y[16];
  if (dir == 0) {
#pragma unroll
    for (int r = 0; r < 16; r++) {
      float a = (r == c) ? 1.f : 0.f;
#pragma unroll
      for (int j = 0; j < 16; j++) if (j < r) a -= Mb[r * 64 + j] * y[j];
      y[r] = a;
    }
  } else {
#pragma unroll
    for (int rr = 0; rr < 16; rr++) {
      const int r = 15 - rr;
      float a = (r == c) ? 1.f : 0.f;
#pragma unroll
      for (int j = 0; j < 16; j++) if (j > r) a -= Mb[r * 64 + j] * y[j];
      y[r] = a;
    }
  }
  float* d = Dv + (dir * 4 + blk) * 256 + c;
#pragma unroll
  for (int r = 0; r < 16; r++) d[r * 16] = y[r];
}

DI void gdn_solve_blocked(CP P, const float* M, const float* Dv, const float* vec, const bf16_t* kb, const bf16_t* vb, int tid, int n0, int h) {
  const int lane = tid & 63, wid = tid >> 6, lr = lane & 15, quad = lane >> 4;
  const int dir = wid >> 1, ch = wid & 1;
  const float* bvec = vec + dir * 64;
  const float* egv = vec + 256 + dir * 64;
  const bf16_t* src = ch ? kb : vb;
  bf16_t* dst = (ch ? P->gw : P->gu) + (size_t)dir * NTOK * 512 + (size_t)n0 * 512 + h * 64;
  bf16x4 XB[4][4];
#pragma unroll
  for (int s = 0; s < 4; s++) {
    const int i = dir ? 3 - s : s;
    f32x4 T[4];
#pragma unroll
    for (int j = 0; j < 4; j++) {
      const int p = i * 16 + quad * 4 + j;
      const float sc = bvec[p] * (ch ? egv[p] : 1.f);
#pragma unroll
      for (int nt = 0; nt < 4; nt++) T[nt][j] = sc * bf2f(src[p * 72 + nt * 16 + lr]);
    }
#pragma unroll
    for (int q = 0; q < 4; q++) {
      if (q < s) {
        const int jb = dir ? 3 - q : q;
        const float4 m4 = *(const float4*)(M + (i * 16 + lr) * 64 + jb * 16 + quad * 4);
        const bf16x4 am = pack4(-m4.x, -m4.y, -m4.z, -m4.w);
#pragma unroll
        for (int nt = 0; nt < 4; nt++) T[nt] = MFMA16K16(am, XB[q][nt], T[nt]);
      }
    }
    const float4 d4 = *(const float4*)(Dv + ((dir * 4 + i) * 16 + lr) * 16 + quad * 4);
    const bf16x4 ad = pack4(d4.x, d4.y, d4.z, d4.w);
#pragma unroll
    for (int nt = 0; nt < 4; nt++) {
      const bf16x4 tb = pack4(T[nt][0], T[nt][1], T[nt][2], T[nt][3]);
      const f32x4 X = MFMA16K16(ad, tb, ((f32x4){0.f, 0.f, 0.f, 0.f}));
      XB[s][nt] = pack4(X[0], X[1], X[2], X[3]);
#pragma unroll
      for (int j = 0; j < 4; j++) dst[(size_t)(i * 16 + quad * 4 + j) * 512 + nt * 16 + lr] = (bf16_t)bf16_sw(X[j]);
    }
  }
}

constexpr int GDNA_N = 192 * 8;

DI void gdn_a_item(CP P, int l, int item, char* smem) {
  const int tid = tidx(), lane = tid & 63, wid = tid >> 6, lr = lane & 15, quad = lane >> 4;
  const int gcx = item >> 3, h = item & 7;
  const int n0 = gcx * 64;
  int s0, s1;
  if (n0 < NCTX) { s0 = n0 & ~255; s1 = s0 + 256; } else { s0 = NCTX + ((n0 - NCTX) & ~4095); s1 = s0 + 4096; }
  bf16_t* kb = (bf16_t*)smem;
  bf16_t* vb = kb + 4608;
  float* M = (float*)(smem + 18432);
  float* vec = M + 4096;
  bf16_t* qb = (bf16_t*)(smem + 36352);
  float* cwl = (float*)(smem + 36352 + 9216);
  float* Dv = (float*)(smem + 36352);
  __syncthreads();
  for (int i = tid; i < 960; i += 256) {
    const int j = i / 192, cc = i % 192, sect = cc >> 6;
    cwl[i] = P->conv[((size_t)l * 5 + j) * 1536 + sect * 512 + h * 64 + (cc & 63)];
  }
  if (wid < 2) {
    const int dir = wid, pp = lane;
    const size_t n = (size_t)n0 + pp;
    const float braw = P->ba[n * 32 + dir * 8 + h];
    const float araw = P->ba[n * 32 + 16 + dir * 8 + h] + P->dt_bias[l * 16 + dir * 8 + h];
    const float sp = araw > 20.f ? araw : log1pf(expf(araw));
    float x = -expf(P->a_log[l * 16 + dir * 8 + h]) * sp;
#pragma unroll
    for (int o = 1; o < 64; o <<= 1) {
      const float yu = __shfl_up(x, o), yd = __shfl_down(x, o);
      if (dir ? (lane + o < 64) : (lane >= o)) x += dir ? yd : yu;
    }
    vec[dir * 64 + pp] = sigmoidf_(braw);
    vec[128 + dir * 64 + pp] = x;
    vec[256 + dir * 64 + pp] = __expf(x);
  }
  __syncthreads();
  {
    const int r = tid >> 2, part = tid & 3;
    const int n = n0 + r;
    float acc[3][16];
#pragma unroll
    for (int sct = 0; sct < 3; sct++)
#pragma unroll
      for (int i = 0; i < 16; i++) acc[sct][i] = 0.f;
#pragma unroll
    for (int j = 0; j < 5; j++) {
      const int nn = n + j - 2;
      if (nn >= s0 && nn < s1) {
#pragma unroll
        for (int sct = 0; sct < 3; sct++) {
          union { uint4 u[2]; bf16_t b[16]; } x;
          const bf16_t* src = P->qkv_raw + (size_t)nn * 1536 + sct * 512 + h * 64 + part * 16;
          x.u[0] = *(const uint4*)src; x.u[1] = *(const uint4*)(src + 8);
          const float* cw = cwl + j * 192 + sct * 64 + part * 16;
#pragma unroll
          for (int i = 0; i < 16; i++) acc[sct][i] += cw[i] * bf2f(x.b[i]);
        }
      }
    }
#pragma unroll
    for (int sct = 0; sct < 3; sct++) {
      float ss = 0.f;
#pragma unroll
      for (int i = 0; i < 16; i++) { acc[sct][i] = siluf_(acc[sct][i]); ss += acc[sct][i] * acc[sct][i]; }
      if (sct < 2) {
        ss += __shfl_xor(ss, 1); ss += __shfl_xor(ss, 2);
        const float sc = rsqrtf(ss + EPS) * (sct == 0 ? 0.125f : 1.f);
#pragma unroll
        for (int i = 0; i < 16; i++) acc[sct][i] *= sc;
      }
      union { uint4 u[2]; unsigned w[8]; } o;
#pragma unroll
      for (int i = 0; i < 8; i++) o.w[i] = pack2(acc[sct][2 * i], acc[sct][2 * i + 1]);
      bf16_t* dl = (sct == 0 ? qb : sct == 1 ? kb : vb) + r * 72 + part * 16;
      *(uint4*)dl = o.u[0]; *(uint4*)(dl + 8) = o.u[1];
      if (sct == 0) { bf16_t* dg = P->gq + (size_t)n * 512 + h * 64 + part * 16; *(uint4*)dg = o.u[0]; *(uint4*)(dg + 8) = o.u[1]; }
    }
  }
  __syncthreads();
  {
    bf16x8 ak[2], aq[2];
#pragma unroll
    for (int ks = 0; ks < 2; ks++) {
      ak[ks] = *(const bf16x8*)(kb + (wid * 16 + lr) * 72 + ks * 32 + quad * 8);
      aq[ks] = *(const bf16x8*)(qb + (wid * 16 + lr) * 72 + ks * 32 + quad * 8);
    }
    const float* b0 = vec; const float* b1 = vec + 64; const float* G0 = vec + 128; const float* G1 = vec + 192;
#pragma unroll
    for (int ni = 0; ni < 4; ni++) {
      f32x4 ckk = (f32x4){0.f, 0.f, 0.f, 0.f}, cqk = (f32x4){0.f, 0.f, 0.f, 0.f};
#pragma unroll
      for (int ks = 0; ks < 2; ks++) {
        const bf16x8 bk = *(const bf16x8*)(kb + (ni * 16 + lr) * 72 + ks * 32 + quad * 8);
        ckk = MFMA16(ak[ks], bk, ckk);
        cqk = MFMA16(aq[ks], bk, cqk);
      }
      const int pp = ni * 16 + lr;
#pragma unroll
      for (int j = 0; j < 4; j++) {
        const int p = wid * 16 + quad * 4 + j;
        float m = 0.f, at0 = 0.f, at1 = 0.f;
        if (pp < p) { const float dec = __expf(G0[p] - G0[pp]); m = b0[p] * ckk[j] * dec; at0 = cqk[j] * dec; }
        else if (pp > p) { const float dec = __expf(G1[p] - G1[pp]); m = b1[p] * ckk[j] * dec; at1 = cqk[j] * dec; }
        else { at0 = cqk[j]; at1 = cqk[j]; }
        M[p * 64 + pp] = m;
        const size_t gi = ((size_t)n0 + p) * 512 + h * 64 + pp;
        P->gattn[gi] = f2bf(at0);
        P->gattn[(size_t)NTOK * 512 + gi] = f2bf(at1);
      }
    }
  }
  {
    const int d = tid >> 2, pg = tid & 3;
    union { uint4 u[2]; bf16_t b[16]; } o;
#pragma unroll
    for (int i = 0; i < 16; i++) o.b[i] = kb[(pg * 16 + i) * 72 + d];
    bf16_t* dg = P->gkT + ((size_t)item * 64 + d) * 64 + pg * 16;
    *(uint4*)dg = o.u[0]; *(uint4*)(dg + 8) = o.u[1];
  }
  if (tid < 128) {
    const int dir = tid >> 6, pp = tid & 63;
    const float glast = dir ? vec[192] : vec[128 + 63];
    const size_t vi = (size_t)dir * NTOK * 8 + ((size_t)n0 + pp) * 8 + h;
    P->geg[vi] = vec[256 + dir * 64 + pp];
    P->gks[vi] = __expf(glast - vec[128 + dir * 64 + pp]);
    if (pp == 0) P->ggl[dir * 1536 + item] = __expf(glast);
  }
  __syncthreads();
  if (tid < 128) gdn_dinv(M, Dv, tid);
  __syncthreads();
  gdn_solve_blocked(P, M, Dv, vec, kb, vb, tid, n0, h);
}

DI void attn_item(const bf16_t* __restrict__ Q, const bf16_t* __restrict__ Kp, const bf16_t* __restrict__ Vt, int vstride, int nA, int tb0, int tb1,
                  int qpos0, bool has_sink, float sinkv, bf16_t* __restrict__ Y, bf16_t* smb) {
  char* sm = (char*)smb;
  const int tid = tidx(), lane = tid & 63, wid = tid >> 6, lr = lane & 15, quad = lane >> 4;
  bf16x8 bq[2][2];
#pragma unroll
  for (int qt = 0; qt < 2; qt++)
#pragma unroll
    for (int ks = 0; ks < 2; ks++) bq[qt][ks] = *(const bf16x8*)(Q + (size_t)(wid * 32 + qt * 16 + lr) * 512 + ks * 32 + quad * 8);
  int offK[4][2], offV[4][2][2];
#pragma unroll
  for (int t = 0; t < 4; t++)
#pragma unroll
    for (int ks = 0; ks < 2; ks++) {
      offK[t][ks] = lds_byte(t * 16 + lr, ks * 32 + quad * 8);
      offV[t][ks][0] = 8192 + lds_byte(t * 16 + lr, ks * 32 + quad * 4);
      offV[t][ks][1] = 8192 + lds_byte(t * 16 + lr, ks * 32 + 16 + quad * 4);
    }
  f32x4 O[4][2];
#pragma unroll
  for (int dt = 0; dt < 4; dt++) { O[dt][0] = (f32x4){0.f, 0.f, 0.f, 0.f}; O[dt][1] = (f32x4){0.f, 0.f, 0.f, 0.f}; }
  float mrun[2];
  f32x4 lsum4[2];
  sinkv *= LOG2E;
  mrun[0] = mrun[1] = has_sink ? sinkv : -1e30f;
  lsum4[0] = lsum4[1] = (f32x4){0.f, 0.f, 0.f, 0.f};
  const int npairs = (nA + (tb1 - tb0)) >> 1, nAp = nA >> 1;
  __syncthreads();
  {
    const int t0 = (nAp > 0 ? 0 : tb0);
    stage_tile<64>(Kp + (size_t)t0 * 4096, 64, sm, tid);
    stage_tile<64>(Vt + t0 * 64, vstride, sm + 8192, tid);
    stage_tile<64>(Kp + (size_t)(t0 + 1) * 4096, 64, sm + 16384, tid);
    stage_tile<64>(Vt + (t0 + 1) * 64, vstride, sm + 24576, tid);
  }
  asm volatile("s_waitcnt vmcnt(0)" ::: "memory");
  __syncthreads();
  for (int ip = 0; ip < npairs; ip++) {
    const bool masked = ip >= nAp;
    const int tile0 = masked ? tb0 + 2 * (ip - nAp) : 2 * ip;
    const int cur = ip & 1;
    if (ip + 1 < npairs) {
      const int tn = (ip + 1 >= nAp) ? tb0 + 2 * (ip + 1 - nAp) : 2 * (ip + 1);
      char* nb = sm + (cur ^ 1) * 32768;
      stage_tile<64>(Kp + (size_t)tn * 4096, 64, nb, tid);
      stage_tile<64>(Vt + tn * 64, vstride, nb + 8192, tid);
      stage_tile<64>(Kp + (size_t)(tn + 1) * 4096, 64, nb + 16384, tid);
      stage_tile<64>(Vt + (tn + 1) * 64, vstride, nb + 24576, tid);
    }
#pragma unroll 1
    for (int sub = 0; sub < 2; sub++) {
    const int p0 = (tile0 + sub) * 64;
    const char* cb = sm + cur * 32768 + sub * 16384;
    f32x4 s[4][2];
    __builtin_amdgcn_s_setprio(1);
#pragma unroll
    for (int kt = 0; kt < 4; kt++) {
      const bf16x8 a0 = *(const bf16x8*)(cb + offK[kt][0]);
      const bf16x8 a1 = *(const bf16x8*)(cb + offK[kt][1]);
#pragma unroll
      for (int qt = 0; qt < 2; qt++) {
        f32x4 t = MFMA16(a0, bq[qt][0], ((f32x4){0.f, 0.f, 0.f, 0.f}));
        s[kt][qt] = MFMA16(a1, bq[qt][1], t);
      }
    }
    __builtin_amdgcn_s_setprio(0);
    if (masked) {
#pragma unroll
      for (int kt = 0; kt < 4; kt++)
#pragma unroll
        for (int qt = 0; qt < 2; qt++)
#pragma unroll
          for (int j = 0; j < 4; j++) {
            const int key = p0 + kt * 16 + quad * 4 + j;
            const int qp = qpos0 + wid * 32 + qt * 16 + lr;
            const int d = key - qp;
            if (d > 128 || d < -128) s[kt][qt][j] = -1e30f;
          }
    }
    float mx[2];
#pragma unroll
    for (int qt = 0; qt < 2; qt++) {
      const f32x4 m01 = __builtin_elementwise_max(s[0][qt], s[1][qt]);
      const f32x4 m23 = __builtin_elementwise_max(s[2][qt], s[3][qt]);
      const f32x4 m4 = __builtin_elementwise_max(m01, m23);
      float m = fmaxf(fmaxf(m4[0], m4[1]), fmaxf(m4[2], m4[3]));
      m = fmaxf(m, __shfl_xor(m, 16));
      m = fmaxf(m, __shfl_xor(m, 32));
      mx[qt] = m;
    }
    if (__any((mx[0] > mrun[0] + 8.f) || (mx[1] > mrun[1] + 8.f))) {
#pragma unroll
      for (int qt = 0; qt < 2; qt++) {
        const float mnew = fmaxf(mrun[qt], mx[qt]);
        const float alpha = __builtin_amdgcn_exp2f(mrun[qt] - mnew);
        mrun[qt] = mnew;
        lsum4[qt] *= alpha;
#pragma unroll
        for (int dt = 0; dt < 4; dt++) O[dt][qt] *= alpha;
      }
    }
#pragma unroll
    for (int qt = 0; qt < 2; qt++) {
      const float mr = mrun[qt];
#pragma unroll
      for (int kt = 0; kt < 4; kt++) {
        const f32x4 d = s[kt][qt] - mr;
        f32x4 pv;
        pv[0] = __builtin_amdgcn_exp2f(d[0]); pv[1] = __builtin_amdgcn_exp2f(d[1]); pv[2] = __builtin_amdgcn_exp2f(d[2]); pv[3] = __builtin_amdgcn_exp2f(d[3]);
        s[kt][qt] = pv;
        lsum4[qt] += pv;
      }
    }
    __builtin_amdgcn_s_setprio(1);
#pragma unroll
    for (int kk = 0; kk < 2; kk++) {
      bf16x8 bp[2];
#pragma unroll
      for (int qt = 0; qt < 2; qt++) {
        bp[qt] = pack8(s[2 * kk][qt][0], s[2 * kk][qt][1], s[2 * kk][qt][2], s[2 * kk][qt][3],
                       s[2 * kk + 1][qt][0], s[2 * kk + 1][qt][1], s[2 * kk + 1][qt][2], s[2 * kk + 1][qt][3]);
      }
#pragma unroll
      for (int dt = 0; dt < 4; dt++) {
        const bf16x4 v0 = *(const bf16x4*)(cb + offV[dt][kk][0]);
        const bf16x4 v1 = *(const bf16x4*)(cb + offV[dt][kk][1]);
        const bf16x8 av = __builtin_shufflevector(v0, v1, 0, 1, 2, 3, 4, 5, 6, 7);
#pragma unroll
        for (int qt = 0; qt < 2; qt++) O[dt][qt] = MFMA16(av, bp[qt], O[dt][qt]);
      }
    }
    __builtin_amdgcn_s_setprio(0);
    }
    asm volatile("s_waitcnt vmcnt(0)" ::: "memory");
    __syncthreads();
  }
#pragma unroll
  for (int qt = 0; qt < 2; qt++) {
    float lt = (lsum4[qt][0] + lsum4[qt][1]) + (lsum4[qt][2] + lsum4[qt][3]);
    lt += __shfl_xor(lt, 16);
    lt += __shfl_xor(lt, 32);
    if (has_sink) lt += __builtin_amdgcn_exp2f(sinkv - mrun[qt]);
    const float inv = 1.f / lt;
    bf16_t* yr = Y + (size_t)(wid * 32 + qt * 16 + lr) * 512;
#pragma unroll
    for (int dt = 0; dt < 4; dt++) {
      uint2 o;
      o.x = pack2(O[dt][qt][0] * inv, O[dt][qt][1] * inv);
      o.y = pack2(O[dt][qt][2] * inv, O[dt][qt][3] * inv);
      *(uint2*)(yr + dt * 16 + quad * 4) = o;
    }
  }
}

DI bf16x8 frag_perm(const bf16_t* base, int row, int kk, int quad) {
  const bf16_t* p = base + row * 72 + kk * 32 + quad * 4;
  const bf16x4 v0 = *(const bf16x4*)p;
  const bf16x4 v1 = *(const bf16x4*)(p + 16);
  return __builtin_shufflevector(v0, v1, 0, 1, 2, 3, 4, 5, 6, 7);
}
DI bf16x8 pack_c2(const f32x4& a, const f32x4& b) { return pack8(a[0], a[1], a[2], a[3], b[0], b[1], b[2], b[3]); }

DI void gdn_scan_item(CP P, int l, int seq, int h, int dir, char* smem) {
  const int tid = tidx(), lane = tid & 63, wid = tid >> 6, lr = lane & 15, quad = lane >> 4;
  const bool ctx = seq < 16;
  const int nch = ctx ? 4 : 64;
  const int n0 = ctx ? seq * 256 : NCTX + (seq - 16) * 4096;
  const int ch0 = n0 >> 6;
  bf16_t* sQ = (bf16_t*)smem;
  bf16_t* sKT = sQ + 4608;
  bf16_t* sW = sKT + 4608;
  bf16_t* sA = sW + 4608;
  bf16_t* sU = sA + 4608;
  float* sEg = (float*)(smem + 46080);
  float* sKs = sEg + 64;
  float* sGl = sKs + 64;
  f32x4 S[4];
  if (ctx) {
#pragma unroll
    for (int mi = 0; mi < 4; mi++) S[mi] = (f32x4){0.f, 0.f, 0.f, 0.f};
  } else {
    const float* src = P->state + ((((size_t)(seq - 16) * 4 + l) * 2 + dir) * 8 + h) * 4096;
#pragma unroll
    for (int mi = 0; mi < 4; mi++)
#pragma unroll
      for (int j = 0; j < 4; j++) S[mi][j] = src[(mi * 16 + quad * 4 + j) * 64 + wid * 16 + lr];
  }
  const size_t doff = (size_t)dir * NTOK * 512;
  uint4 pq0, pq1, pk0, pk1, pw0, pw1, pa0, pa1, pu0, pu1;
  float pv = 0.f;
  const int lrow = tid >> 3, lcol = (tid & 7) * 8;
#define GDN_ISSUE1(i_, Q_, K_, W_, A_, U_) { \
      const size_t ro = tb + (size_t)(lrow + 32 * (i_)) * 512 + lcol; \
      Q_ = *(const uint4*)(P->gq + ro); \
      K_ = *(const uint4*)(P->gkT + ((size_t)((ch0 + c__) * 8 + h) * 64 + lrow + 32 * (i_)) * 64 + lcol); \
      W_ = *(const uint4*)(P->gw + doff + ro); \
      A_ = *(const uint4*)(P->gattn + doff + ro); \
      U_ = *(const uint4*)(P->gu + doff + ro); }
#define GDN_ISSUE(c_) do { const int c__ = (c_); \
    const size_t tb = ((size_t)n0 + c__ * 64) * 512 + h * 64; \
    GDN_ISSUE1(0, pq0, pk0, pw0, pa0, pu0) \
    GDN_ISSUE1(1, pq1, pk1, pw1, pa1, pu1) \
    if (tid < 64) pv = P->geg[(size_t)dir * NTOK * 8 + ((size_t)n0 + c__ * 64 + tid) * 8 + h]; \
    else if (tid < 128) pv = P->gks[(size_t)dir * NTOK * 8 + ((size_t)n0 + c__ * 64 + tid - 64) * 8 + h]; \
    else if (tid == 128) pv = P->ggl[dir * 1536 + (ch0 + c__) * 8 + h]; \
  } while (0)
  GDN_ISSUE(dir ? nch - 1 : 0);
  for (int cc = 0; cc < nch; cc++) {
    const int c = dir ? nch - 1 - cc : cc;
    __syncthreads();
    {
      const int so0 = lrow * 72 + lcol, so1 = (lrow + 32) * 72 + lcol;
      *(uint4*)(sQ + so0) = pq0; *(uint4*)(sQ + so1) = pq1;
      *(uint4*)(sKT + so0) = pk0; *(uint4*)(sKT + so1) = pk1;
      *(uint4*)(sW + so0) = pw0; *(uint4*)(sW + so1) = pw1;
      *(uint4*)(sA + so0) = pa0; *(uint4*)(sA + so1) = pa1;
      *(uint4*)(sU + so0) = pu0; *(uint4*)(sU + so1) = pu1;
    }
    if (tid < 64) sEg[tid] = pv; else if (tid < 128) sKs[tid - 64] = pv; else if (tid == 128) sGl[0] = pv;
    __syncthreads();
    if (cc + 1 < nch) GDN_ISSUE(dir ? nch - 2 - cc : cc + 1);
    bf16x8 sB[2];
    sB[0] = pack_c2(S[0], S[1]);
    sB[1] = pack_c2(S[2], S[3]);
    f32x4 U[4], QS[4];
#pragma unroll
    for (int mi = 0; mi < 4; mi++) {
      f32x4 aw = (f32x4){0.f, 0.f, 0.f, 0.f}, aq = (f32x4){0.f, 0.f, 0.f, 0.f};
#pragma unroll
      for (int kk = 0; kk < 2; kk++) {
        aw = MFMA16(frag_perm(sW, mi * 16 + lr, kk, quad), sB[kk], aw);
        aq = MFMA16(frag_perm(sQ, mi * 16 + lr, kk, quad), sB[kk], aq);
      }
#pragma unroll
      for (int j = 0; j < 4; j++) U[mi][j] = bf2f(sU[(mi * 16 + quad * 4 + j) * 72 + wid * 16 + lr]) - aw[j];
      QS[mi] = aq;
    }
    bf16x8 uB[2], usB[2];
    {
      f32x4 t[4];
#pragma unroll
      for (int mi = 0; mi < 4; mi++)
#pragma unroll
        for (int j = 0; j < 4; j++) t[mi][j] = U[mi][j] * sKs[mi * 16 + quad * 4 + j];
      uB[0] = pack_c2(U[0], U[1]); uB[1] = pack_c2(U[2], U[3]);
      usB[0] = pack_c2(t[0], t[1]); usB[1] = pack_c2(t[2], t[3]);
    }
    bf16_t* og = P->obf + doff + ((size_t)n0 + c * 64) * 512 + h * 64 + wid * 16 + lr;
#pragma unroll
    for (int mi = 0; mi < 4; mi++) {
      f32x4 aa = (f32x4){0.f, 0.f, 0.f, 0.f};
#pragma unroll
      for (int kk = 0; kk < 2; kk++) aa = MFMA16(frag_perm(sA, mi * 16 + lr, kk, quad), uB[kk], aa);
#pragma unroll
      for (int j = 0; j < 4; j++) {
        const int pr = mi * 16 + quad * 4 + j;
        og[(size_t)pr * 512] = f2bf(sEg[pr] * QS[mi][j] + aa[j]);
      }
    }
    const float gl = sGl[0];
#pragma unroll
    for (int mi = 0; mi < 4; mi++) {
      f32x4 ak = (f32x4){0.f, 0.f, 0.f, 0.f};
#pragma unroll
      for (int kk = 0; kk < 2; kk++) ak = MFMA16(frag_perm(sKT, mi * 16 + lr, kk, quad), usB[kk], ak);
#pragma unroll
      for (int j = 0; j < 4; j++) S[mi][j] = gl * S[mi][j] + ak[j];
    }
  }
  if (ctx) {
    float* dst = P->out + OUT_ST + ((((size_t)seq * 4 + l) * 2 + dir) * 8 + h) * 4096;
#pragma unroll
    for (int mi = 0; mi < 4; mi++)
#pragma unroll
      for (int j = 0; j < 4; j++) dst[(mi * 16 + quad * 4 + j) * 64 + wid * 16 + lr] = S[mi][j];
  }
}

constexpr int MIX_GL = 32, MIX_BL = 512, MIX_CL = 512, MIX_GC = 256, MIX_BC = 256, MIX_CC = 256;
constexpr int MIX_N = MIX_GL + MIX_BL + MIX_CL + MIX_GC + MIX_BC + MIX_CC;

DI void mix_item(CP P, int l, int item, char* smem) {
  if (item < MIX_GL) { gdn_scan_item(P, l, 16 + (item >> 4), (item >> 1) & 7, item & 1, smem); return; }
  item -= MIX_GL;
  if (item < MIX_BL + MIX_CL) {
    const int typeC = item >= MIX_BL;
    const int i = typeC ? item - MIX_BL : item;
    const int b = i >> 8, head = (i >> 5) & 7, qb = i & 31, kvh = head >> 2;
    const size_t tok0 = (size_t)NCTX + b * 4096 + qb * 128;
    const bf16_t* Q = (typeC ? P->qC : P->qB) + tok0 * 512 + head * 64;
    const bf16_t* Kp = (typeC ? P->kfC : P->kfB) + (size_t)(b * 2 + kvh) * LFULL * 64;
    const bf16_t* Vt = (typeC ? P->vtfC : P->vtfB) + (size_t)(b * 2 + kvh) * 64 * LFULL;
    bf16_t* Y = (typeC ? P->yc : P->yb) + tok0 * 512 + head * 64;
    if (!typeC) {
      attn_item(Q, Kp, Vt, LFULL, 72, 0, 0, 0, false, 0.f, Y, (bf16_t*)smem);
    } else {
      const int start = qb * 128;
      const int lo = start - 128 < 0 ? 0 : start - 128;
      const int hi = start + 256 > 4096 ? 4096 : start + 256;
      attn_item(Q, Kp, Vt, LFULL, 8, (512 + lo) >> 6, (512 + hi) >> 6, 512 + start, true, P->sink[l * 8 + head], Y, (bf16_t*)smem);
    }
    return;
  }
  item -= MIX_BL + MIX_CL;
  if (item < MIX_GC) { gdn_scan_item(P, l, item >> 4, (item >> 1) & 7, item & 1, smem); return; }
  item -= MIX_GC;
  {
    const int typeC = item >= MIX_BC;
    const int i = typeC ? item - MIX_BC : item;
    const int b = i >> 4, head = (i >> 1) & 7, qb = i & 1, kvh = head >> 2;
    const size_t tok0 = (size_t)b * 256 + qb * 128;
    const bf16_t* Q = (typeC ? P->qC : P->qB) + tok0 * 512 + head * 64;
    const bf16_t* Kp = (typeC ? P->kcC : P->kcB) + (size_t)(b * 2 + kvh) * 256 * 64;
    const bf16_t* Vt = (typeC ? P->vtcC : P->vtcB) + (size_t)(b * 2 + kvh) * 64 * 256;
    bf16_t* Y = (typeC ? P->yc : P->yb) + tok0 * 512 + head * 64;
    attn_item(Q, Kp, Vt, 256, 4, 0, 0, 0, typeC != 0, typeC ? P->sink[l * 8 + head] : 0.f, Y, (bf16_t*)smem);
  }
}

constexpr int GDNOUT_N = NTOK / 4;
DI void gdnout_item(CP P, int l, int item) {
  const int tid = tidx(), lane = tid & 63, wid = tid >> 6;
  const size_t base = (size_t)(item * 4 + wid) * 512 + lane;
  float o[8], zz[8];
#pragma unroll
  for (int hh = 0; hh < 8; hh++) {
    const size_t idx = base + hh * 64;
    o[hh] = bf2f(P->obf[idx]) + bf2f(P->obf[(size_t)NTOK * 512 + idx]);
    zz[hh] = bf2f(P->z[idx]);
  }
  const float an = P->a_norm[l * 64 + lane];
#pragma unroll
  for (int hh = 0; hh < 8; hh++) {
    const float ss = wave_sum(o[hh] * o[hh]);
    const float on = o[hh] * rsqrtf(ss * (1.f / 64.f) + EPS) * an;
    P->ya[base + hh * 64] = f2bf(on * siluf_(zz[hh]));
  }
}

#define XB_TMO      128
#define XB_XCNT(j)  (256  + 64 * (j))
#define XB_XSUB(j)  (1280 + 64 * (j))
#define XB_XGEN(j)  (2304 + 64 * (j))
#define XB_TOP      3328
#define XB_TOPGEN   3392
#define XCD_BAR_WORDS 3456
#define XB_SPIN_CAP (1u << 22)
#define LAS __attribute__((address_space(3)))
DI unsigned xb_ld(unsigned* p) { return __hip_atomic_load(p, __ATOMIC_RELAXED, __HIP_MEMORY_SCOPE_AGENT); }
DI unsigned xb_add(unsigned* p, unsigned v) { return __hip_atomic_fetch_add(p, v, __ATOMIC_RELAXED, __HIP_MEMORY_SCOPE_AGENT); }
DI unsigned xb_xcc_id() { return (unsigned)__builtin_amdgcn_s_getreg((3 << 11) | 20) & 0xFu; }
#define XB_SPIN(cond, bar) do { unsigned _sp = 0; while (cond) { __builtin_amdgcn_s_sleep(1); \
    if ((++_sp & 255u) == 0u) { if (xb_ld(&(bar)[XB_TMO])) break; if (_sp > XB_SPIN_CAP) { atomicAdd(&(bar)[XB_TMO], 1u); break; } } } } while (0)
struct XcdBarrier { unsigned* bar; unsigned x; volatile LAS unsigned* st; };
DI XcdBarrier xcd_barrier_post(unsigned* bar, volatile LAS unsigned* st) {
  XcdBarrier b; b.bar = bar; b.x = xb_xcc_id(); b.st = st;
  if (threadIdx.x == 0) (void)xb_add(&bar[XB_XCNT(b.x)], 1u);
  return b;
}
DI void xcd_barrier_complete(unsigned* bar, unsigned x, unsigned& nloc, unsigned& nx) {
  const unsigned G = gridDim.x * gridDim.y * gridDim.z;
  unsigned sum, cnt, mine, sp = 0u;
  for (;;) {
    sum = 0u; cnt = 0u; mine = 0u;
#pragma unroll
    for (unsigned j = 0; j < 16; ++j) { const unsigned c = xb_ld(&bar[XB_XCNT(j)]); sum += c; cnt += (c > 0u) ? 1u : 0u; mine = (j == x) ? c : mine; }
    if (sum == G) break;
    __builtin_amdgcn_s_sleep(1);
    if ((++sp & 255u) == 0u) { if (xb_ld(&bar[XB_TMO])) break; if (sp > XB_SPIN_CAP) { atomicAdd(&bar[XB_TMO], 1u); break; } }
  }
  nloc = mine > 0u ? mine : 1u; nx = cnt > 0u ? cnt : 1u;
}
DI void xcd_barrier(const XcdBarrier& b) {
  asm volatile("s_waitcnt vmcnt(0)" ::: "memory");
  __syncthreads();
  if (threadIdx.x == 0) {
    unsigned* bar = b.bar;
    __builtin_amdgcn_s_waitcnt(0);
    unsigned nloc = b.st[0], nx = b.st[1];
    if (nloc == 0u) { xcd_barrier_complete(bar, b.x, nloc, nx); b.st[0] = nloc; b.st[1] = nx; }
    const unsigned old = xb_add(&bar[XB_XSUB(b.x)], 1u);
    const unsigned gen = old / nloc;
    if (old + 1u == (gen + 1u) * nloc) {
      __builtin_amdgcn_fence(__ATOMIC_RELEASE, "agent");
      asm volatile("s_waitcnt vmcnt(0)" ::: "memory");
      const unsigned og = xb_add(&bar[XB_TOP], 1u);
      const unsigned tg = og / nx;
      if (og + 1u == (tg + 1u) * nx) xb_add(&bar[XB_TOPGEN], 1u);
      else XB_SPIN(xb_ld(&bar[XB_TOPGEN]) == tg, bar);
      __builtin_amdgcn_fence(__ATOMIC_ACQUIRE, "agent");
      xb_add(&bar[XB_XGEN(b.x)], 1u);
      asm volatile("s_waitcnt vmcnt(0)" ::: "memory");
    } else {
      XB_SPIN(xb_ld(&bar[XB_XGEN(b.x)]) == gen, bar);
      __builtin_amdgcn_fence(__ATOMIC_ACQUIRE, "agent");
      asm volatile("s_waitcnt vmcnt(0)" ::: "memory");
    }
  }
  __syncthreads();
}

enum { PH_PREP = 0, PH_NORM1, PH_GEMM_IN, PH_FEAT, PH_MIX, PH_GDNOUT, PH_GEMM_BR, PH_GEMM_O, PH_NORM2, PH_FF1, PH_FF2, PH_COUNT };

__host__ __device__ inline int phase_count(int ph) {
  switch (ph) {
    case PH_PREP: return PREP_N;
    case PH_NORM1: return NORM1_N;
    case PH_GEMM_IN: return GEMM_IN_N;
    case PH_FEAT: return GDNA_N;
    case PH_MIX: return MIX_N;
    case PH_GDNOUT: return GDNOUT_N;
    case PH_GEMM_BR: return GEMM_BR_N;
    case PH_GEMM_O: return GEMM_RES_N;
    case PH_NORM2: return NORM_ROWS;
    case PH_FF1: return GEMM_FF1_N;
    case PH_FF2: return GEMM_FF2R_N;
  }
  return 0;
}

DI void run_item(CP P, int ph, int l, int item, char* smem) {
  switch (ph) {
    case PH_PREP: prep_item(P, item, smem); break;
    case PH_NORM1: if (item < NORM_ROWS) modnorm_item(P, l, 0, item); else cache_item(P, l, item - NORM_ROWS); break;
    case PH_GEMM_IN: gemm_in_item(P, l, item, smem); break;
    case PH_FEAT: gdn_a_item(P, l, item, smem); break;
    case PH_MIX: mix_item(P, l, item, smem); break;
    case PH_GDNOUT: gdnout_item(P, l, item); break;
    case PH_GEMM_BR: gemm_br_item(P, l, item, smem); break;
    case PH_GEMM_O: gemm_res_item(P, l, item, smem, P->h, 1024, P->wt_o + (size_t)l * 1024 * 1024, 2048); break;
    case PH_NORM2: modnorm_item(P, l, 1, item); break;
    case PH_FF1: gemm_ff1_item(P, l, item, smem); break;
    case PH_FF2: gemm_ff2_ring_item(P, l, item, smem); break;
  }
}

#if !MEGA
template <int PH>
__global__ void __launch_bounds__(256, 2) k_phase(Params Pk, int l) {
  __shared__ __attribute__((aligned(16))) char smem[SMEM_BYTES];
  CP P = launder_params();
  const int n = phase_count(PH);
  for (int item = blockIdx.x; item < n; item += gridDim.x) run_item(P, PH, l, item, smem);
}
#else
template <int PH>
DI void phase_loop(int l, char* smem) {
  CP P = launder_params();
  const int n = phase_count(PH);
#pragma unroll 1
  for (int item = blockIdx.x; item < n; item += gridDim.x) run_item(P, PH, l, item, smem);
}

#ifndef PROBE_PH
#define PROBE_PH -1
#endif
#define GSYNC() xcd_barrier(xb)
#define RUNPH(PH_) do { phase_loop<PH_>(l, smem); GSYNC(); if (PROBE_PH == PH_) { phase_loop<PH_>(l, smem); GSYNC(); } } while (0)

DI void mix_loop(int l, unsigned* ctr, char* smem, int* s_item) {
  CP P = launder_params();
#pragma unroll 1
  for (;;) {
    __syncthreads();
    if (threadIdx.x == 0) *s_item = (int)atomicAdd(ctr, 1u);
    __syncthreads();
    const int item = *s_item;
    if (item >= MIX_N) break;
    run_item(P, PH_MIX, l, item, smem);
  }
}

__global__ void __launch_bounds__(256, 2) k_mega(Params Pk) {
  __shared__ __attribute__((aligned(16))) char smem[SMEM_BYTES];
  __shared__ uint4 xb_words;
  __shared__ int s_item;
  cg::grid_group grid = cg::this_grid();
  if (threadIdx.x == 0) xb_words = make_uint4(0u, 0u, 0u, 0u);
  __syncthreads();
  const XcdBarrier xb = xcd_barrier_post(launder_params()->bar, (volatile LAS unsigned*)&xb_words);
  phase_loop<PH_PREP>(0, smem);
  if (launder_params()->never) grid.sync();
  GSYNC();
  if (PROBE_PH == PH_PREP) { phase_loop<PH_PREP>(0, smem); GSYNC(); }
#pragma unroll 1
  for (int l = 0; l < 4; l++) {
    RUNPH(PH_NORM1);
    RUNPH(PH_GEMM_IN);
    RUNPH(PH_FEAT);
    mix_loop(l, launder_params()->counters + l, smem, &s_item);
    GSYNC();
    if (PROBE_PH == PH_MIX) { mix_loop(l, launder_params()->counters + 8 + l, smem, &s_item); GSYNC(); }
    RUNPH(PH_GDNOUT);
    RUNPH(PH_GEMM_BR);
    phase_loop<PH_GEMM_O>(l, smem); GSYNC();
    RUNPH(PH_NORM2);
    RUNPH(PH_FF1);
    phase_loop<PH_FF2>(l, smem); GSYNC();
  }
}
#endif

static inline size_t align_up(size_t x) { return (x + 255) & ~(size_t)255; }

extern "C" void kernel_launch(void* const* d_in, const int* in_sizes, int n_in, void* d_out, int out_size, void* d_ws, size_t ws_size, hipStream_t stream) {
  Params P;
  memset(&P, 0, sizeof(P));
  P.x_prompt = (const float*)d_in[0]; P.x_sample = (const float*)d_in[1];
  P.ckg = (const float*)d_in[2]; P.cvg = (const float*)d_in[3]; P.ckw = (const float*)d_in[4]; P.cvw = (const float*)d_in[5];
  P.state = (const float*)d_in[6]; P.c = (const float*)d_in[7]; P.c_ctx = (const float*)d_in[8];
  P.w_mod = (const float*)d_in[9]; P.b_mod = (const float*)d_in[10]; P.ln1 = (const float*)d_in[11]; P.ln2 = (const float*)d_in[12];
  P.w_in = (const float*)d_in[13]; P.conv = (const float*)d_in[14]; P.a_log = (const float*)d_in[15]; P.dt_bias = (const float*)d_in[16];
  P.a_norm = (const float*)d_in[17]; P.qk_norm = (const float*)d_in[18]; P.sink = (const float*)d_in[19];
  P.w_br_a = (const float*)d_in[20]; P.w_br_b = (const float*)d_in[21]; P.w_br_c = (const float*)d_in[22];
  P.w_o = (const float*)d_in[23]; P.w_ff1 = (const float*)d_in[24]; P.w_ff2 = (const float*)d_in[25];
  P.out = (float*)d_out;
  char* ws = (char*)d_ws;
  size_t off = 0;
  auto take = [&](size_t bytes) { char* p = ws + off; off = align_up(off + bytes); return p; };
  P.wt_in = (bf16_t*)take((size_t)4 * NCOLP * 1024 * 2);
  P.wt_br = (bf16_t*)take((size_t)4 * 3 * 1024 * 512 * 2);
  P.wt_o = (bf16_t*)take((size_t)4 * 1024 * 1024 * 2);
  P.wt_ff1 = (bf16_t*)take((size_t)4 * 4096 * 1024 * 2);
  P.wt_ff2 = (bf16_t*)take((size_t)4 * 4096 * 1024 * 2);
  P.mods = (float*)take((size_t)4 * 3 * 6144 * 4);
  P.ropec = (float*)take((size_t)4096 * 32 * 4);
  P.ropes = (float*)take((size_t)4096 * 32 * 4);
  P.counters = (unsigned*)take(1024);
  P.bar = (unsigned*)take((size_t)XCD_BAR_WORDS * 4);
  P.h = (bf16_t*)take((size_t)NTOK * DM * 2);
  P.kfB = (bf16_t*)take((size_t)4 * LFULL * 64 * 2);
  P.vtfB = (bf16_t*)take((size_t)4 * LFULL * 64 * 2);
  P.kfC = (bf16_t*)take((size_t)4 * LFULL * 64 * 2);
  P.vtfC = (bf16_t*)take((size_t)4 * LFULL * 64 * 2);
  P.kcB = (bf16_t*)take((size_t)32 * 256 * 64 * 2);
  P.vtcB = (bf16_t*)take((size_t)32 * 256 * 64 * 2);
  P.kcC = (bf16_t*)take((size_t)32 * 256 * 64 * 2);
  P.vtcC = (bf16_t*)take((size_t)32 * 256 * 64 * 2);
  P.ba = (float*)take((size_t)NTOK * 32 * 4);
  P.bg = (float*)take((size_t)NTOK * 32 * 4);
  P.yb = (bf16_t*)take((size_t)NTOK * 512 * 2);
  P.yc = (bf16_t*)take((size_t)NTOK * 512 * 2);
  P.qC = (bf16_t*)take((size_t)NTOK * 512 * 2);
  char* fregion = take((size_t)NTOK * DFF * 2);
  P.f = (bf16_t*)fregion;
  P.gates = (bf16_t*)fregion;
  P.z = (bf16_t*)(fregion + (size_t)NTOK * 3072 * 2);
  P.qB = (bf16_t*)(fregion + (size_t)NTOK * 3072 * 2 + (size_t)NTOK * 512 * 2);
  P.gq = (bf16_t*)take((size_t)NTOK * 512 * 2);
  P.gkT = (bf16_t*)take((size_t)NTOK * 512 * 2);
  P.gw = (bf16_t*)take((size_t)2 * NTOK * 512 * 2);
  P.gu = (bf16_t*)take((size_t)2 * NTOK * 512 * 2);
  P.gattn = P.h;
  P.geg = (float*)take((size_t)2 * NTOK * 8 * 4);
  P.gks = (float*)take((size_t)2 * NTOK * 8 * 4);
  P.ggl = (float*)take((size_t)2 * 1536 * 4);
  P.ya = P.gq;
  char* oregion = take((size_t)NTOK * 1536 * 2);
  P.obf = (bf16_t*)oregion;
  P.qkv_raw = (bf16_t*)oregion;
  if (off > ws_size) { fprintf(stderr, "workspace too small: need %zu have %zu\n", off, ws_size); return; }

#if !MEGA
#define LAUNCH(PH, l) hipLaunchKernelGGL(k_phase<PH>, dim3(phase_count(PH) < 8192 ? phase_count(PH) : 8192), dim3(256), 0, stream, P, l)
  LAUNCH(PH_PREP, 0);
  for (int l = 0; l < 4; l++) {
    LAUNCH(PH_NORM1, l); LAUNCH(PH_GEMM_IN, l); LAUNCH(PH_FEAT, l); LAUNCH(PH_MIX, l); LAUNCH(PH_GDNOUT, l);
    LAUNCH(PH_GEMM_BR, l); LAUNCH(PH_GEMM_O, l); LAUNCH(PH_NORM2, l); LAUNCH(PH_FF1, l); LAUNCH(PH_FF2, l);
  }
#else
  static int grid_blocks = 0;
  if (!grid_blocks) {
    int dev = 0, cus = 0, per_cu = 0;
    hipGetDevice(&dev);
    hipDeviceGetAttribute(&cus, hipDeviceAttributeMultiprocessorCount, dev);
    hipOccupancyMaxActiveBlocksPerMultiprocessor(&per_cu, k_mega, 256, 0);
    if (per_cu > 2) per_cu = 2;
    grid_blocks = cus * per_cu;
  }
  hipMemsetAsync(P.bar, 0, (size_t)XCD_BAR_WORDS * 4, stream);
  void* args[] = {&P};
  hipError_t e = hipLaunchCooperativeKernel((void*)k_mega, dim3(grid_blocks), dim3(256), args, 0, stream);
  if (e != hipSuccess) fprintf(stderr, "cooperative launch failed: %s (grid %d)\n", hipGetErrorString(e), grid_blocks);
#endif
}
```

```cpp
#include <hip/hip_runtime.h>
#include <hip/hip_cooperative_groups.h>
#include <stdint.h>
#include <stdio.h>
#include <string.h>
namespace cg = cooperative_groups;

#ifndef MEGA
#define MEGA 1
#endif

typedef unsigned short bf16_t;
typedef __attribute__((ext_vector_type(8))) short bf16x8;
typedef __attribute__((ext_vector_type(4))) short bf16x4;
typedef __attribute__((ext_vector_type(4))) float f32x4;
#define DI __device__ __forceinline__
#define MFMA16(a, b, c) __builtin_amdgcn_mfma_f32_16x16x32_bf16((a), (b), (c), 0, 0, 0)

constexpr int NTOK = 12288, NCTX = 4096, DM = 1024, NCOLP = 6784, INCOLS = 6688, DFF = 4096;
constexpr int LFULL = 4608;
constexpr float EPS = 1e-6f;
constexpr float LOG2E = 1.4426950408889634f;
constexpr float QSCALE = 0.125f * LOG2E;
constexpr size_t OUT_KG = 12582912, OUT_VG = 14680064, OUT_KW = 16777216, OUT_VW = 18874368, OUT_ST = 20971520;
constexpr int SMEM_BYTES = 73728;

struct Params {
  const float *x_prompt, *x_sample, *ckg, *cvg, *ckw, *cvw, *state, *c, *c_ctx, *w_mod, *b_mod, *ln1, *ln2, *w_in, *conv,
      *a_log, *dt_bias, *a_norm, *qk_norm, *sink, *w_br_a, *w_br_b, *w_br_c, *w_o, *w_ff1, *w_ff2;
  float* out;
  bf16_t *wt_in, *wt_br, *wt_o, *wt_ff1, *wt_ff2;
  float *mods, *ropec, *ropes;
  unsigned* counters;
  unsigned* bar;
  long long never;
  bf16_t* h;
  bf16_t *qkv_raw, *z, *qB, *qC, *gates;
  float *ba, *bg;
  bf16_t *gq, *gkT, *gw, *gu, *gattn, *obf;
  float *geg, *gks, *ggl;
  bf16_t *kfB, *vtfB, *kfC, *vtfC;
  bf16_t *kcB, *vtcB, *kcC, *vtcC;
  bf16_t *ya, *yb, *yc;
  bf16_t* f;
};

typedef const __attribute__((address_space(4))) Params* CP;

DI CP launder_params() {
  CP cp = (CP)__builtin_amdgcn_kernarg_segment_ptr();
  asm volatile("" : "+s"(cp));
  return cp;
}

DI float bf2f(bf16_t x) { return __uint_as_float(((unsigned)x) << 16); }
DI unsigned pack2(float a, float b) { unsigned r; asm("v_cvt_pk_bf16_f32 %0, %1, %2" : "=v"(r) : "v"(a), "v"(b)); return r; }
DI bf16_t f2bf(float f) { unsigned u = __float_as_uint(f); u += 0x7fffu + ((u >> 16) & 1u); return (bf16_t)(u >> 16); }
typedef __attribute__((ext_vector_type(4))) unsigned u32x4_t;
DI bf16x8 pack8(float x0, float x1, float x2, float x3, float x4, float x5, float x6, float x7) {
  u32x4_t p;
  asm volatile("v_cvt_pk_bf16_f32 %0, %4, %5\n\tv_cvt_pk_bf16_f32 %1, %6, %7\n\tv_cvt_pk_bf16_f32 %2, %8, %9\n\tv_cvt_pk_bf16_f32 %3, %10, %11\n\ts_nop 1"
               : "=&v"(p[0]), "=&v"(p[1]), "=&v"(p[2]), "=&v"(p[3])
               : "v"(x0), "v"(x1), "v"(x2), "v"(x3), "v"(x4), "v"(x5), "v"(x6), "v"(x7));
  return __builtin_bit_cast(bf16x8, p);
}
DI int tidx() { int t = threadIdx.x; asm volatile("" : "+v"(t)); return t; }
DI float wave_sum(float v) {
#pragma unroll
  for (int o = 32; o > 0; o >>= 1) v += __shfl_xor(v, o);
  return v;
}
DI float sigmoidf_(float x) { return 1.f / (1.f + __expf(-x)); }
DI float siluf_(float x) { return x / (1.f + __expf(-x)); }
DI int mod_index(int n) { return n < NCTX ? 0 : 1 + ((n - NCTX) >> 12); }

constexpr int PREP_MODS = 384, PREP_TRL = 4384, PREP_TR = 4 * PREP_TRL, PREP_XC = 768, PREP_ROPE = 32, PREP_MISC = 1;
constexpr int PREP_N = PREP_MODS + PREP_TR + PREP_XC + PREP_ROPE + PREP_MISC;

DI void tr_tile(const float* __restrict__ src, int ldsrc, int srccol0, int nvalid, bf16_t* __restrict__ dst, int ldd, int n0, int k0, float* tile) {
  const int tid = tidx();
  {
    const int nn4 = (tid & 15) * 4;
#pragma unroll
    for (int i = 0; i < 4; i++) {
      const int kk = (tid >> 4) + 16 * i;
      float4 v = make_float4(0.f, 0.f, 0.f, 0.f);
      if (nn4 < nvalid) v = *(const float4*)(src + (size_t)(k0 + kk) * ldsrc + srccol0 + nn4);
      tile[kk * 65 + nn4 + 0] = v.x; tile[kk * 65 + nn4 + 1] = v.y; tile[kk * 65 + nn4 + 2] = v.z; tile[kk * 65 + nn4 + 3] = v.w;
    }
  }
  __syncthreads();
  {
    const int kk4 = (tid & 15) * 4;
#pragma unroll
    for (int i = 0; i < 4; i++) {
      const int nn = (tid >> 4) + 16 * i;
      uint2 o;
      o.x = pack2(tile[(kk4 + 0) * 65 + nn], tile[(kk4 + 1) * 65 + nn]);
      o.y = pack2(tile[(kk4 + 2) * 65 + nn], tile[(kk4 + 3) * 65 + nn]);
      *(uint2*)(dst + (size_t)(n0 + nn) * ldd + k0 + kk4) = o;
    }
  }
  __syncthreads();
}

DI void prep_item(CP P, int item, char* smem) {
  const int tid = tidx(), lane = tid & 63, wid = tid >> 6;
  float* sm = (float*)smem;
  if (item < PREP_MODS) {
    const int l = item / 96, jb = item % 96;
    float* ssil = sm;
    float* red = sm + 3072;
    for (int k = tid; k < 1024; k += 256) {
      ssil[k] = siluf_(P->c_ctx[k]);
      ssil[1024 + k] = siluf_(P->c[k]);
      ssil[2048 + k] = siluf_(P->c[1024 + k]);
    }
    __syncthreads();
    const float* W = P->w_mod + (size_t)l * 1024 * 6144 + jb * 64 + lane;
    float a0 = 0.f, a1 = 0.f, a2 = 0.f;
    const int kb = wid * 256;
#pragma unroll 8
    for (int k = 0; k < 256; k++) {
      const float w = W[(size_t)(kb + k) * 6144];
      a0 += ssil[kb + k] * w; a1 += ssil[1024 + kb + k] * w; a2 += ssil[2048 + kb + k] * w;
    }
    red[(wid * 3 + 0) * 64 + lane] = a0; red[(wid * 3 + 1) * 64 + lane] = a1; red[(wid * 3 + 2) * 64 + lane] = a2;
    __syncthreads();
    if (tid < 192) {
      const int m = tid >> 6, jj = tid & 63;
      float s = 0.f;
      for (int w = 0; w < 4; w++) s += red[(w * 3 + m) * 64 + jj];
      P->mods[((size_t)l * 3 + m) * 6144 + jb * 64 + jj] = s + P->b_mod[(size_t)l * 6144 + jb * 64 + jj];
    }
    __syncthreads();
    return;
  }
  item -= PREP_MODS;
  if (item < PREP_TR) {
    const int l = item / PREP_TRL; int s = item % PREP_TRL;
    if (s < 1696) {
      const int nt = s / 16, kt = s % 16;
      int srccol0 = nt * 64, nvalid = 64;
      if (nt == 32) { srccol0 = 2048; nvalid = 32; } else if (nt > 32 && nt < 105) { srccol0 = nt * 64 - 32; } else if (nt >= 105) { nvalid = 0; srccol0 = 0; }
      tr_tile(P->w_in + (size_t)l * 1024 * INCOLS, INCOLS, srccol0, nvalid, P->wt_in + (size_t)l * NCOLP * 1024, 1024, nt * 64, kt * 64, sm);
      return;
    }
    s -= 1696;
    if (s < 384) {
      const int which = s / 128, r = s % 128, nt = r / 8, kt = r % 8;
      const float* src = (which == 0 ? P->w_br_a : which == 1 ? P->w_br_b : P->w_br_c) + (size_t)l * 512 * 1024;
      tr_tile(src, 1024, nt * 64, 64, P->wt_br + (size_t)(l * 3 + which) * 1024 * 512, 512, nt * 64, kt * 64, sm);
      return;
    }
    s -= 384;
    if (s < 256) {
      const int nt = s / 16, kt = s % 16;
      tr_tile(P->w_o + (size_t)l * 1024 * 1024, 1024, nt * 64, 64, P->wt_o + (size_t)l * 1024 * 1024, 1024, nt * 64, kt * 64, sm);
      return;
    }
    s -= 256;
    if (s < 1024) {
      const int nt = s / 16, kt = s % 16;
      tr_tile(P->w_ff1 + (size_t)l * 1024 * 4096, 4096, nt * 64, 64, P->wt_ff1 + (size_t)l * 4096 * 1024, 1024, nt * 64, kt * 64, sm);
      return;
    }
    s -= 1024;
    {
      const int nt = s / 64, kt = s % 64;
      tr_tile(P->w_ff2 + (size_t)l * 4096 * 1024, 1024, nt * 64, 64, P->wt_ff2 + (size_t)l * 1024 * 4096, 4096, nt * 64, kt * 64, sm);
      return;
    }
  }
  item -= PREP_TR;
  if (item < PREP_XC) {
    const size_t base = (size_t)item * 16384;
    const float4* src = (const float4*)(base < 4194304 ? P->x_prompt + base : P->x_sample + (base - 4194304));
    float4* dst = (float4*)(P->out + base);
#pragma unroll 4
    for (int i = 0; i < 16; i++) dst[tid + 256 * i] = src[tid + 256 * i];
    return;
  }
  item -= PREP_XC;
  if (item < PREP_ROPE) {
    for (int i = 0; i < 16; i++) {
      const int e = item * 4096 + tid + 256 * i;
      const int t = e >> 5, i2 = e & 31;
      const int pos = (i2 < 16) ? (t >> 6) : (t & 63);
      const int fi = i2 & 15;
      const float inv = exp2f(-(float)fi * (13.287712379549449f / 16.f));
      const float ang = (float)pos * inv;
      P->ropec[e] = cosf(ang);
      P->ropes[e] = sinf(ang);
    }
    return;
  }
  item -= PREP_ROPE;
  if (tid < 64) P->counters[tid] = 0u;
}

constexpr int NORM_ROWS = NTOK / 8;
constexpr int NORM1_N = NORM_ROWS + 512;

DI void modnorm_item(CP P, int l, int which, int item) {
  const int tid = tidx(), lane = tid & 63, wid = tid >> 6;
  const int nb = item * 8 + wid * 2;
  float4 v[2][4];
  float ss[2];
#pragma unroll
  for (int r = 0; r < 2; r++) {
    const float* xr = P->out + (size_t)(nb + r) * DM;
#pragma unroll
    for (int i = 0; i < 4; i++) v[r][i] = *(const float4*)(xr + lane * 4 + 256 * i);
  }
  const float* md = P->mods + ((size_t)l * 3 + mod_index(nb)) * 6144;
  const float* sh = md + (which ? 3072 : 0);
  const float* sc = md + (which ? 4096 : 1024);
  const float* lw = (which ? P->ln2 : P->ln1) + (size_t)l * DM;
  float4 w4[4], s4[4], h4[4];
#pragma unroll
  for (int i = 0; i < 4; i++) {
    const int c = lane * 4 + 256 * i;
    w4[i] = *(const float4*)(lw + c); s4[i] = *(const float4*)(sc + c); h4[i] = *(const float4*)(sh + c);
    w4[i].x *= 1.f + s4[i].x; w4[i].y *= 1.f + s4[i].y; w4[i].z *= 1.f + s4[i].z; w4[i].w *= 1.f + s4[i].w;
  }
#pragma unroll
  for (int r = 0; r < 2; r++) {
    float a = 0.f;
#pragma unroll
    for (int i = 0; i < 4; i++) a += v[r][i].x * v[r][i].x + v[r][i].y * v[r][i].y + v[r][i].z * v[r][i].z + v[r][i].w * v[r][i].w;
    ss[r] = wave_sum(a);
  }
#pragma unroll
  for (int r = 0; r < 2; r++) {
    const float rstd = rsqrtf(ss[r] * (1.f / 1024.f) + EPS);
#pragma unroll
    for (int i = 0; i < 4; i++) {
      const int c = lane * 4 + 256 * i;
      uint2 o;
      o.x = pack2(v[r][i].x * rstd * w4[i].x + h4[i].x, v[r][i].y * rstd * w4[i].y + h4[i].y);
      o.y = pack2(v[r][i].z * rstd * w4[i].z + h4[i].z, v[r][i].w * rstd * w4[i].w + h4[i].w);
      *(uint2*)(P->h + (size_t)(nb + r) * DM + c) = o;
    }
  }
}

DI void cache_item(CP P, int l, int item) {
  const int tid = tidx();
  const int type = item >> 8, b = (item >> 7) & 1, pg = item & 127;
  const float* ck = type ? P->ckw : P->ckg;
  const float* cv = type ? P->cvw : P->cvg;
  bf16_t* kf = type ? P->kfC : P->kfB;
  bf16_t* vtf = type ? P->vtfC : P->vtfB;
#pragma unroll
  for (int i = 0; i < 2; i++) {
    const int e = tid + 256 * i;
    const int pl = e >> 7, c = e & 127, kvh = c >> 6, d = c & 63;
    const int pos = pg * 4 + pl;
    const size_t si = ((((size_t)b * 4 + l) * 512 + pos) * 2 + kvh) * 64 + d;
    kf[((size_t)(b * 2 + kvh) * LFULL + pos) * 64 + d] = f2bf(ck[si]);
    vtf[((size_t)(b * 2 + kvh) * 64 + d) * LFULL + pos] = f2bf(cv[si]);
  }
}

DI int lds_byte(int r, int c) { const int st = (r >> 4) * 2 + (c >> 5), rr = r & 15, cc = c & 31, ob = rr * 64 + cc * 2; return st * 1024 + (ob ^ (((ob >> 9) & 1) << 5)); }
DI void stage_rc(int b, int& R, int& C) { const int st = b >> 10, sb = b & 1023, swz = sb ^ (((sb >> 9) & 1) << 5); R = (st >> 1) * 16 + (swz >> 6); C = (st & 1) * 32 + ((swz & 63) >> 1); }

template <int ROWS>
DI void stage_tile(const bf16_t* __restrict__ g, int ld, char* lds, int tid) {
#pragma unroll
  for (int i = 0; i < ROWS / 32; i++) {
    const int b = tid * 16 + i * 4096;
    int R, C;
    stage_rc(b, R, C);
    __builtin_amdgcn_global_load_lds((const unsigned*)(g + (size_t)R * ld + C), (unsigned*)(lds + b), 16, 0, 0);
  }
}

template <int NI>
DI void gemm_mainloop(const bf16_t* __restrict__ A, int lda, const bf16_t* __restrict__ Bt, int ldb, int K, int m0, int n0, bf16_t* smb, f32x4 (&acc)[4][NI]) {
  char* sm = (char*)smb;
  const int tid = tidx(), lane = tid & 63, wid = tid >> 6, wm = wid >> 1, wn = wid & 1, lr = lane & 15, quad = lane >> 4;
  const bf16_t* ga = A + (size_t)m0 * lda;
  const bf16_t* gb = Bt + (size_t)n0 * ldb;
  int offA[4][2], offB[NI][2];
#pragma unroll
  for (int ks = 0; ks < 2; ks++) {
#pragma unroll
    for (int mi = 0; mi < 4; mi++) offA[mi][ks] = lds_byte(wm * 64 + mi * 16 + lr, ks * 32 + quad * 8);
#pragma unroll
    for (int ni = 0; ni < NI; ni++) offB[ni][ks] = 16384 + lds_byte(wn * 16 * NI + ni * 16 + lr, ks * 32 + quad * 8);
  }
  __syncthreads();
  stage_tile<128>(ga, lda, sm, tid);
  stage_tile<32 * NI>(gb, ldb, sm + 16384, tid);
  asm volatile("s_waitcnt vmcnt(0)" ::: "memory");
  __syncthreads();
  const int nk = K >> 6;
  for (int kt = 0; kt < nk; kt++) {
    const int cur = kt & 1;
    if (kt + 1 < nk) {
      char* nb = sm + (cur ^ 1) * 32768;
      stage_tile<128>(ga + (kt + 1) * 64, lda, nb, tid);
      stage_tile<32 * NI>(gb + (kt + 1) * 64, ldb, nb + 16384, tid);
    }
    const char* cb = sm + cur * 32768;
#pragma unroll
    for (int ks = 0; ks < 2; ks++) {
      bf16x8 af[4], bfr[NI];
#pragma unroll
      for (int mi = 0; mi < 4; mi++) af[mi] = *(const bf16x8*)(cb + offA[mi][ks]);
#pragma unroll
      for (int ni = 0; ni < NI; ni++) bfr[ni] = *(const bf16x8*)(cb + offB[ni][ks]);
#pragma unroll
      for (int mi = 0; mi < 4; mi++)
#pragma unroll
        for (int ni = 0; ni < NI; ni++) acc[mi][ni] = MFMA16(af[mi], bfr[ni], acc[mi][ni]);
    }
    asm volatile("s_waitcnt vmcnt(0)" ::: "memory");
    __syncthreads();
  }
}

template <int MI, int NI>
DI void gemm_mainloop3(const bf16_t* __restrict__ A, int lda, const bf16_t* __restrict__ Bt, int ldb, int K, int m0, int n0, char* sm, f32x4 (&acc)[MI][NI]) {
  constexpr int A_BYTES = 32 * MI * 64, B_BYTES = 32 * NI * 64, STAGE = A_BYTES + B_BYTES;
  static_assert(3 * STAGE <= SMEM_BYTES, "LDS");
  const int tid = tidx(), lane = tid & 63, wid = tid >> 6, wm = wid >> 1, wn = wid & 1, lr = lane & 15, quad = lane >> 4;
  const int sb = (tid * 16) & 1023, swz = sb ^ (((sb >> 9) & 1) << 5), rr = swz >> 6, cc = (swz & 63) >> 1;
  const bf16_t* ga = A + (size_t)(m0 + wid * 16 + rr) * lda + cc;
  const bf16_t* gb = Bt + (size_t)(n0 + wid * 16 + rr) * ldb + cc;
  const int lane_off = (lr * 64 + quad * 16) ^ (((lr >> 3) & 1) << 5);
  const int offA = (wm * MI) * 1024 + lane_off, offB = A_BYTES + (wn * NI) * 1024 + lane_off;
#define G3_STAGE(buf_, kt_) do { char* d_ = sm + (buf_) * STAGE + tid * 16; const int ko_ = (kt_) * 32; \
    _Pragma("unroll") for (int i = 0; i < MI / 2; i++) __builtin_amdgcn_global_load_lds((const unsigned*)(ga + (size_t)(i * 64) * lda + ko_), (unsigned*)(d_ + i * 4096), 16, 0, 0); \
    _Pragma("unroll") for (int i = 0; i < NI / 2; i++) __builtin_amdgcn_global_load_lds((const unsigned*)(gb + (size_t)(i * 64) * ldb + ko_), (unsigned*)(d_ + A_BYTES + i * 4096), 16, 0, 0); \
  } while (0)
  const int nk = K >> 5;
  __syncthreads();
  G3_STAGE(0, 0);
  G3_STAGE(1, 1);
  int cur = 0;
  for (int kt = 0; kt < nk; kt++) {
    if (kt + 1 < nk) asm volatile("s_waitcnt vmcnt(%0)" ::"n"(MI / 2 + NI / 2) : "memory");
    else asm volatile("s_waitcnt vmcnt(0)" ::: "memory");
    __builtin_amdgcn_s_barrier();
    asm volatile("" ::: "memory");
    const char* cb = sm + cur * STAGE;
    bf16x8 af[MI], bfr[NI];
#pragma unroll
    for (int mi = 0; mi < MI; mi++) af[mi] = *(const bf16x8*)(cb + offA + mi * 1024);
#pragma unroll
    for (int ni = 0; ni < NI; ni++) bfr[ni] = *(const bf16x8*)(cb + offB + ni * 1024);
    if (kt + 2 < nk) { const int nb = cur >= 1 ? cur - 1 : 2; G3_STAGE(nb, kt + 2); }
#pragma unroll
    for (int mi = 0; mi < MI; mi++)
#pragma unroll
      for (int ni = 0; ni < NI; ni++) acc[mi][ni] = MFMA16(af[mi], bfr[ni], acc[mi][ni]);
    cur = cur == 2 ? 0 : cur + 1;
  }
#undef G3_STAGE
}

template <int MI, int NI>
DI void zero_acc2(f32x4 (&acc)[MI][NI]) {
#pragma unroll
  for (int i = 0; i < MI; i++)
#pragma unroll
    for (int j = 0; j < NI; j++) acc[i][j] = (f32x4){0.f, 0.f, 0.f, 0.f};
}

template <int NI>
DI void zero_acc(f32x4 (&acc)[4][NI]) {
#pragma unroll
  for (int i = 0; i < 4; i++)
#pragma unroll
    for (int j = 0; j < NI; j++) acc[i][j] = (f32x4){0.f, 0.f, 0.f, 0.f};
}

DI bool tile_map(int item, int MT, int NT, int& mt, int& nt) {
  const int r = item >> 9, within = item & 511, x = within & 7, q = within >> 3;
  const int patch = r * 8 + x, pmn = MT >> 3;
  mt = (patch % pmn) * 8 + (q & 7);
  nt = (patch / pmn) * 8 + (q >> 3);
  return nt < NT;
}

constexpr int GEMM_IN_N = 48 * 53;

DI void gemm_in_item(CP P, int l, int item, char* smem) {
  const int mt = item % 48, nt = item / 48;
  const int m0 = mt * 256, n0 = nt * 128;
  f32x4 acc[8][4];
  zero_acc2<8, 4>(acc);
  gemm_mainloop3<8, 4>(P->h, DM, P->wt_in + (size_t)l * NCOLP * 1024, 1024, 1024, m0, n0, smem, acc);
  const int tid = tidx(), lane = tid & 63, wid = tid >> 6, wm = wid >> 1, wn = wid & 1, lr = lane & 15, quad = lane >> 4;
  const int row0 = m0 + wm * 128, col0 = n0 + wn * 64;
  const int w64 = col0 >> 6;
  if (w64 < 24) {
#pragma unroll
    for (int mi = 0; mi < 8; mi++)
#pragma unroll
      for (int j = 0; j < 4; j++) {
        const size_t row = row0 + mi * 16 + quad * 4 + j;
#pragma unroll
        for (int ni = 0; ni < 4; ni++) P->qkv_raw[row * 1536 + w64 * 64 + ni * 16 + lr] = f2bf(acc[mi][ni][j]);
      }
  } else if (w64 < 32) {
#pragma unroll
    for (int mi = 0; mi < 8; mi++)
#pragma unroll
      for (int j = 0; j < 4; j++) {
        const size_t row = row0 + mi * 16 + quad * 4 + j;
#pragma unroll
        for (int ni = 0; ni < 4; ni++) P->z[row * 512 + (w64 - 24) * 64 + ni * 16 + lr] = f2bf(acc[mi][ni][j]);
      }
  } else if (w64 == 32) {
#pragma unroll
    for (int mi = 0; mi < 8; mi++)
#pragma unroll
      for (int j = 0; j < 4; j++) {
        const size_t row = row0 + mi * 16 + quad * 4 + j;
#pragma unroll
        for (int ni = 0; ni < 2; ni++) P->ba[row * 32 + ni * 16 + lr] = acc[mi][ni][j];
      }
  } else if (w64 < 57) {
    const int hidx = w64 - 33;
    const int typeC = hidx >= 12;
    const int hh = typeC ? hidx - 12 : hidx;
    const bool isq = hh < 8, isk = (hh == 8 || hh == 9), isv = hh >= 10;
    const int kvh = isk ? hh - 8 : (isv ? hh - 10 : 0);
    const bool latent = row0 >= NCTX;
    const float* qn = P->qk_norm + ((size_t)l * 4 + (typeC ? 2 : 0) + (isk ? 1 : 0)) * 64;
    float qw[4];
#pragma unroll
    for (int ni = 0; ni < 4; ni++) qw[ni] = qn[ni * 16 + lr];
#pragma unroll
    for (int mi = 0; mi < 8; mi++)
#pragma unroll
      for (int j = 0; j < 4; j++) {
        const int row = row0 + mi * 16 + quad * 4 + j;
        float val[4];
#pragma unroll
        for (int ni = 0; ni < 4; ni++) val[ni] = acc[mi][ni][j];
        if (!isv) {
          float ss = val[0] * val[0] + val[1] * val[1] + val[2] * val[2] + val[3] * val[3];
          ss += __shfl_xor(ss, 1); ss += __shfl_xor(ss, 2); ss += __shfl_xor(ss, 4); ss += __shfl_xor(ss, 8);
          const float rstd = rsqrtf(ss * (1.f / 64.f) + EPS);
#pragma unroll
          for (int ni = 0; ni < 4; ni++) val[ni] = val[ni] * rstd * qw[ni];
        }
        if (!latent) {
          const int b = row >> 8, t = row & 255;
          if (isq) {
            bf16_t* q = (typeC ? P->qC : P->qB) + (size_t)row * 512 + hh * 64;
#pragma unroll
            for (int ni = 0; ni < 4; ni++) q[ni * 16 + lr] = f2bf(val[ni] * QSCALE);
          } else if (isk) {
            bf16_t* kc = (typeC ? P->kcC : P->kcB) + ((size_t)(b * 2 + kvh) * 256 + t) * 64;
            float* ko = P->out + (typeC ? OUT_KW : OUT_KG) + (((size_t)(b * 4 + l) * 256 + t) * 2 + kvh) * 64;
#pragma unroll
            for (int ni = 0; ni < 4; ni++) { kc[ni * 16 + lr] = f2bf(val[ni]); ko[ni * 16 + lr] = val[ni]; }
          } else {
            bf16_t* vt = (typeC ? P->vtcC : P->vtcB) + (size_t)(b * 2 + kvh) * 64 * 256 + t;
            float* vo = P->out + (typeC ? OUT_VW : OUT_VG) + (((size_t)(b * 4 + l) * 256 + t) * 2 + kvh) * 64;
#pragma unroll
            for (int ni = 0; ni < 4; ni++) { vt[(size_t)(ni * 16 + lr) * 256] = f2bf(val[ni]); vo[ni * 16 + lr] = val[ni]; }
          }
        } else {
          const int b = (row - NCTX) >> 12, t = (row - NCTX) & 4095;
          if (!isv) {
            const float c0 = P->ropec[t * 32 + lr], c1 = P->ropec[t * 32 + 16 + lr];
            const float s0 = P->ropes[t * 32 + lr], s1 = P->ropes[t * 32 + 16 + lr];
            const float x10 = val[0], x11 = val[1], x20 = val[2], x21 = val[3];
            val[0] = x10 * c0 - x20 * s0; val[2] = x20 * c0 + x10 * s0;
            val[1] = x11 * c1 - x21 * s1; val[3] = x21 * c1 + x11 * s1;
          }
          if (isq) {
            bf16_t* q = (typeC ? P->qC : P->qB) + (size_t)row * 512 + hh * 64;
#pragma unroll
            for (int ni = 0; ni < 4; ni++) q[ni * 16 + lr] = f2bf(val[ni] * QSCALE);
          } else if (isk) {
            bf16_t* kf = (typeC ? P->kfC : P->kfB) + ((size_t)(b * 2 + kvh) * LFULL + 512 + t) * 64;
#pragma unroll
            for (int ni = 0; ni < 4; ni++) kf[ni * 16 + lr] = f2bf(val[ni]);
          } else {
            bf16_t* vt = (typeC ? P->vtfC : P->vtfB) + (size_t)(b * 2 + kvh) * 64 * LFULL + 512 + t;
#pragma unroll
            for (int ni = 0; ni < 4; ni++) vt[(size_t)(ni * 16 + lr) * LFULL] = f2bf(val[ni]);
          }
        }
      }
  } else if (w64 < 105) {
#pragma unroll
    for (int mi = 0; mi < 8; mi++)
#pragma unroll
      for (int j = 0; j < 4; j++) {
        const size_t row = row0 + mi * 16 + quad * 4 + j;
#pragma unroll
        for (int ni = 0; ni < 4; ni++) P->gates[row * 3072 + (w64 - 57) * 64 + ni * 16 + lr] = f2bf(sigmoidf_(acc[mi][ni][j]));
      }
  }
}

constexpr int GEMM_D_N = 96 * 8;
constexpr int GEMM_BR_N = 96 * 16;

DI void gemm_br_item(CP P, int l, int item, char* smem) {
  const int mt = item % 96, nt = item / 96;
  const int m0 = mt * 128, n0 = nt * 64;
  const int tid = tidx(), lane = tid & 63, wid = tid >> 6, wm = wid >> 1, wn = wid & 1, lr = lane & 15, quad = lane >> 4;
  const int row0 = m0 + wm * 64, col0 = n0 + wn * 32;
  f32x4 tot[4][2];
  zero_acc<2>(tot);
#pragma unroll 1
  for (int br = 0; br < 3; br++) {
    f32x4 acc[4][2];
    zero_acc<2>(acc);
    const bf16_t* A = br == 0 ? P->ya : br == 1 ? P->yb : P->yc;
    gemm_mainloop<2>(A, 512, P->wt_br + (size_t)(l * 3 + br) * 1024 * 512, 512, 512, m0, n0, (bf16_t*)smem, acc);
#pragma unroll
    for (int mi = 0; mi < 4; mi++)
#pragma unroll
      for (int j = 0; j < 4; j++) {
        const size_t row = row0 + mi * 16 + quad * 4 + j;
#pragma unroll
        for (int ni = 0; ni < 2; ni++) tot[mi][ni][j] += bf2f(P->gates[row * 3072 + br * 1024 + col0 + ni * 16 + lr]) * acc[mi][ni][j];
      }
  }
#pragma unroll
  for (int mi = 0; mi < 4; mi++)
#pragma unroll
    for (int j = 0; j < 4; j++) {
      const size_t row = row0 + mi * 16 + quad * 4 + j;
#pragma unroll
      for (int ni = 0; ni < 2; ni++) P->h[row * DM + col0 + ni * 16 + lr] = f2bf(tot[mi][ni][j]);
    }
}

constexpr int GEMM_RES_N = 1024;
template <int NI>
DI void gemm_res_tile(CP P, int l, char* smem, const bf16_t* A, int K, const bf16_t* Bt, int gate_off, int m0, int n0) {
  f32x4 acc[4][NI];
  zero_acc<NI>(acc);
  gemm_mainloop<NI>(A, K, Bt, K, K, m0, n0, (bf16_t*)smem, acc);
  const int tid = tidx(), lane = tid & 63, wid = tid >> 6, wm = wid >> 1, wn = wid & 1, lr = lane & 15, quad = lane >> 4;
  const int row0 = m0 + wm * 64, col0 = n0 + wn * 16 * NI;
  const float* g = P->mods + ((size_t)l * 3 + mod_index(row0)) * 6144 + gate_off + col0;
  float gv[NI];
#pragma unroll
  for (int ni = 0; ni < NI; ni++) gv[ni] = g[ni * 16 + lr];
#pragma unroll
  for (int mi = 0; mi < 4; mi++)
#pragma unroll
    for (int j = 0; j < 4; j++) {
      const size_t row = row0 + mi * 16 + quad * 4 + j;
#pragma unroll
      for (int ni = 0; ni < NI; ni++) {
        float* xp = P->out + row * DM + col0 + ni * 16 + lr;
        *xp = *xp + gv[ni] * acc[mi][ni][j];
      }
    }
}
DI void gemm_res_item(CP P, int l, int item, char* smem, const bf16_t* A, int K, const bf16_t* Bt, int gate_off) {
  if (item < 512) {
    gemm_res_tile<4>(P, l, smem, A, K, Bt, gate_off, (item % 96) * 128, (item / 96) * 128);
  } else {
    const int hi = item - 512, tile = 512 + (hi >> 1);
    gemm_res_tile<2>(P, l, smem, A, K, Bt, gate_off, (tile % 96) * 128, (tile / 96) * 128 + (hi & 1) * 64);
  }
}

constexpr int GEMM_FF2R_N = 64 * 8;
DI void gemm_res_ring_item(CP P, int l, int item, char* smem, const bf16_t* A, int K, const bf16_t* Bt, int gate_off) {
  const int mt = item % 64, nt = item / 64;
  const int m0 = mt * 192, n0 = nt * 128;
  f32x4 acc[6][4];
  zero_acc2<6, 4>(acc);
  gemm_mainloop3<6, 4>(A, K, Bt, K, K, m0, n0, smem, acc);
  const int tid = tidx(), lane = tid & 63, wid = tid >> 6, wm = wid >> 1, wn = wid & 1, lr = lane & 15, quad = lane >> 4;
  const int row0 = m0 + wm * 96, col0 = n0 + wn * 64;
#pragma unroll
  for (int mi = 0; mi < 6; mi++) {
    const float* g = P->mods + ((size_t)l * 3 + mod_index(row0 + mi * 16)) * 6144 + gate_off + col0;
    float gv[4];
#pragma unroll
    for (int ni = 0; ni < 4; ni++) gv[ni] = g[ni * 16 + lr];
#pragma unroll
    for (int j = 0; j < 4; j++) {
      const size_t row = row0 + mi * 16 + quad * 4 + j;
#pragma unroll
      for (int ni = 0; ni < 4; ni++) {
        float* xp = P->out + row * DM + col0 + ni * 16 + lr;
        *xp = *xp + gv[ni] * acc[mi][ni][j];
      }
    }
  }
}

constexpr int GEMM_FF1_N = 48 * 32;
DI void gemm_ff1_item(CP P, int l, int item, char* smem) {
  int mt, nt;
  tile_map(item, 48, 32, mt, nt);
  const int m0 = mt * 256, n0 = nt * 128;
  f32x4 acc[8][4];
  zero_acc2<8, 4>(acc);
  gemm_mainloop3<8, 4>(P->h, DM, P->wt_ff1 + (size_t)l * DFF * 1024, 1024, 1024, m0, n0, smem, acc);
  const int tid = tidx(), lane = tid & 63, wid = tid >> 6, wm = wid >> 1, wn = wid & 1, lr = lane & 15, quad = lane >> 4;
  const int row0 = m0 + wm * 128, col0 = n0 + wn * 64;
#pragma unroll
  for (int mi = 0; mi < 8; mi++)
#pragma unroll
    for (int j = 0; j < 4; j++) {
      const size_t row = row0 + mi * 16 + quad * 4 + j;
#pragma unroll
      for (int ni = 0; ni < 4; ni++) {
        const float r = fmaxf(acc[mi][ni][j], 0.f);
        P->f[row * DFF + col0 + ni * 16 + lr] = f2bf(r * r);
      }
    }
}

#define MFMA16K16(a, b, c) __builtin_amdgcn_mfma_f32_16x16x16bf16_1k((a), (b), (c), 0, 0, 0)
DI unsigned bf16_sw(float f) { unsigned u = __float_as_uint(f); u += 0x7fffu + ((u >> 16) & 1u); return u >> 16; }
DI bf16x4 pack4(float x0, float x1, float x2, float x3) {
  typedef __attribute__((ext_vector_type(2))) unsigned u32x2_t;
  u32x2_t t;
  t[0] = bf16_sw(x0) | (bf16_sw(x1) << 16);
  t[1] = bf16_sw(x2) | (bf16_sw(x3) << 16);
  return __builtin_bit_cast(bf16x4, t);
}

DI void gdn_dinv(const float* M, float* Dv, int tid) {
  const int dir = tid >> 6, blk = (tid >> 4) & 3, c = tid & 15;
  const float* Mb = M + (blk * 16) * 64 + blk * 16;
  float y[16];
  if (dir == 0) {
#pragma unroll
    for (int r = 0; r < 16; r++) {
      float a = (r == c) ? 1.f : 0.f;
#pragma unroll
      for (int j = 0; j < 16; j++) if (j < r) a -= Mb[r * 64 + j] * y[j];
      y[r] = a;
    }
  } else {
#pragma unroll
    for (int rr = 0; rr < 16; rr++) {
      const int r = 15 - rr;
      float a = (r == c) ? 1.f : 0.f;
#pragma unroll
      for (int j = 0; j < 16; j++) if (j > r) a -= Mb[r * 64 + j] * y[j];
      y[r] = a;
    }
  }
  float* d = Dv + (dir * 4 + blk) * 256 + c;
#pragma unroll
  for (int r = 0; r < 16; r++) d[r * 16] = y[r];
}

DI void gdn_solve_blocked(CP P, const float* M, const float* Dv, const float* vec, const bf16_t* kb, const bf16_t* vb, int tid, int n0, int h) {
  const int lane = tid & 63, wid = tid >> 6, lr = lane & 15, quad = lane >> 4;
  const int dir = wid >> 1, ch = wid & 1;
  const float* bvec = vec + dir * 64;
  const float* egv = vec + 256 + dir * 64;
  const bf16_t* src = ch ? kb : vb;
  bf16_t* dst = (ch ? P->gw : P->gu) + (size_t)dir * NTOK * 512 + (size_t)n0 * 512 + h * 64;
  bf16x4 XB[4][4];
#pragma unroll
  for (int s = 0; s < 4; s++) {
    const int i = dir ? 3 - s : s;
    f32x4 T[4];
#pragma unroll
    for (int j = 0; j < 4; j++) {
      const int p = i * 16 + quad * 4 + j;
      const float sc = bvec[p] * (ch ? egv[p] : 1.f);
#pragma unroll
      for (int nt = 0; nt < 4; nt++) T[nt][j] = sc * bf2f(src[p * 72 + nt * 16 + lr]);
    }
#pragma unroll
    for (int q = 0; q < 4; q++) {
      if (q < s) {
        const int jb = dir ? 3 - q : q;
        const float4 m4 = *(const float4*)(M + (i * 16 + lr) * 64 + jb * 16 + quad * 4);
        const bf16x4 am = pack4(-m4.x, -m4.y, -m4.z, -m4.w);
#pragma unroll
        for (int nt = 0; nt < 4; nt++) T[nt] = MFMA16K16(am, XB[q][nt], T[nt]);
      }
    }
    const float4 d4 = *(const float4*)(Dv + ((dir * 4 + i) * 16 + lr) * 16 + quad * 4);
    const bf16x4 ad = pack4(d4.x, d4.y, d4.z, d4.w);
#pragma unroll
    for (int nt = 0; nt < 4; nt++) {
      const bf16x4 tb = pack4(T[nt][0], T[nt][1], T[nt][2], T[nt][3]);
      const f32x4 X = MFMA16K16(ad, tb, ((f32x4){0.f, 0.f, 0.f, 0.f}));
      XB[s][nt] = pack4(X[0], X[1], X[2], X[3]);
#pragma unroll
      for (int j = 0; j < 4; j++) dst[(size_t)(i * 16 + quad * 4 + j) * 512 + nt * 16 + lr] = (bf16_t)bf16_sw(X[j]);
    }
  }
}

constexpr int GDNA_N = 192 * 8;

DI void gdn_a_item(CP P, int l, int item, char* smem) {
  const int tid = tidx(), lane = tid & 63, wid = tid >> 6, lr = lane & 15, quad = lane >> 4;
  const int gcx = item >> 3, h = item & 7;
  const int n0 = gcx * 64;
  int s0, s1;
  if (n0 < NCTX) { s0 = n0 & ~255; s1 = s0 + 256; } else { s0 = NCTX + ((n0 - NCTX) & ~4095); s1 = s0 + 4096; }
  bf16_t* kb = (bf16_t*)smem;
  bf16_t* vb = kb + 4608;
  float* M = (float*)(smem + 18432);
  float* vec = M + 4096;
  bf16_t* qb = (bf16_t*)(smem + 36352);
  float* cwl = (float*)(smem + 36352 + 9216);
  float* Dv = (float*)(smem + 36352);
  __syncthreads();
  for (int i = tid; i < 960; i += 256) {
    const int j = i / 192, cc = i % 192, sect = cc >> 6;
    cwl[i] = P->conv[((size_t)l * 5 + j) * 1536 + sect * 512 + h * 64 + (cc & 63)];
  }
  if (wid < 2) {
    const int dir = wid, pp = lane;
    const size_t n = (size_t)n0 + pp;
    const float braw = P->ba[n * 32 + dir * 8 + h];
    const float araw = P->ba[n * 32 + 16 + dir * 8 + h] + P->dt_bias[l * 16 + dir * 8 + h];
    const float sp = araw > 20.f ? araw : log1pf(expf(araw));
    float x = -expf(P->a_log[l * 16 + dir * 8 + h]) * sp;
#pragma unroll
    for (int o = 1; o < 64; o <<= 1) {
      const float yu = __shfl_up(x, o), yd = __shfl_down(x, o);
      if (dir ? (lane + o < 64) : (lane >= o)) x += dir ? yd : yu;
    }
    vec[dir * 64 + pp] = sigmoidf_(braw);
    vec[128 + dir * 64 + pp] = x;
    vec[256 + dir * 64 + pp] = __expf(x);
  }
  __syncthreads();
  {
    const int r = tid >> 2, part = tid & 3;
    const int n = n0 + r;
    float acc[3][16];
#pragma unroll
    for (int sct = 0; sct < 3; sct++)
#pragma unroll
      for (int i = 0; i < 16; i++) acc[sct][i] = 0.f;
#pragma unroll
    for (int j = 0; j < 5; j++) {
      const int nn = n + j - 2;
      if (nn >= s0 && nn < s1) {
#pragma unroll
        for (int sct = 0; sct < 3; sct++) {
          union { uint4 u[2]; bf16_t b[16]; } x;
          const bf16_t* src = P->qkv_raw + (size_t)nn * 1536 + sct * 512 + h * 64 + part * 16;
          x.u[0] = *(const uint4*)src; x.u[1] = *(const uint4*)(src + 8);
          const float* cw = cwl + j * 192 + sct * 64 + part * 16;
#pragma unroll
          for (int i = 0; i < 16; i++) acc[sct][i] += cw[i] * bf2f(x.b[i]);
        }
      }
    }
#pragma unroll
    for (int sct = 0; sct < 3; sct++) {
      float ss = 0.f;
#pragma unroll
      for (int i = 0; i < 16; i++) { acc[sct][i] = siluf_(acc[sct][i]); ss += acc[sct][i] * acc[sct][i]; }
      if (sct < 2) {
        ss += __shfl_xor(ss, 1); ss += __shfl_xor(ss, 2);
        const float sc = rsqrtf(ss + EPS) * (sct == 0 ? 0.125f : 1.f);
#pragma unroll
        for (int i = 0; i < 16; i++) acc[sct][i] *= sc;
      }
      union { uint4 u[2]; unsigned w[8]; } o;
#pragma unroll
      for (int i = 0; i < 8; i++) o.w[i] = pack2(acc[sct][2 * i], acc[sct][2 * i + 1]);
      bf16_t* dl = (sct == 0 ? qb : sct == 1 ? kb : vb) + r * 72 + part * 16;
      *(uint4*)dl = o.u[0]; *(uint4*)(dl + 8) = o.u[1];
      if (sct == 0) { bf16_t* dg = P->gq + (size_t)n * 512 + h * 64 + part * 16; *(uint4*)dg = o.u[0]; *(uint4*)(dg + 8) = o.u[1]; }
    }
  }
  __syncthreads();
  {
    bf16x8 ak[2], aq[2];
#pragma unroll
    for (int ks = 0; ks < 2; ks++) {
      ak[ks] = *(const bf16x8*)(kb + (wid * 16 + lr) * 72 + ks * 32 + quad * 8);
      aq[ks] = *(const bf16x8*)(qb + (wid * 16 + lr) * 72 + ks * 32 + quad * 8);
    }
    const float* b0 = vec; const float* b1 = vec + 64; const float* G0 = vec + 128; const float* G1 = vec + 192;
#pragma unroll
    for (int ni = 0; ni < 4; ni++) {
      f32x4 ckk = (f32x4){0.f, 0.f, 0.f, 0.f}, cqk = (f32x4){0.f, 0.f, 0.f, 0.f};
#pragma unroll
      for (int ks = 0; ks < 2; ks++) {
        const bf16x8 bk = *(const bf16x8*)(kb + (ni * 16 + lr) * 72 + ks * 32 + quad * 8);
        ckk = MFMA16(ak[ks], bk, ckk);
        cqk = MFMA16(aq[ks], bk, cqk);
      }
      const int pp = ni * 16 + lr;
#pragma unroll
      for (int j = 0; j < 4; j++) {
        const int p = wid * 16 + quad * 4 + j;
        float m = 0.f, at0 = 0.f, at1 = 0.f;
        if (pp < p) { const float dec = __expf(G0[p] - G0[pp]); m = b0[p] * ckk[j] * dec; at0 = cqk[j] * dec; }
        else if (pp > p) { const float dec = __expf(G1[p] - G1[pp]); m = b1[p] * ckk[j] * dec; at1 = cqk[j] * dec; }
        else { at0 = cqk[j]; at1 = cqk[j]; }
        M[p * 64 + pp] = m;
        const size_t gi = ((size_t)n0 + p) * 512 + h * 64 + pp;
        P->gattn[gi] = f2bf(at0);
        P->gattn[(size_t)NTOK * 512 + gi] = f2bf(at1);
      }
    }
  }
  {
    const int d = tid >> 2, pg = tid & 3;
    union { uint4 u[2]; bf16_t b[16]; } o;
#pragma unroll
    for (int i = 0; i < 16; i++) o.b[i] = kb[(pg * 16 + i) * 72 + d];
    bf16_t* dg = P->gkT + ((size_t)item * 64 + d) * 64 + pg * 16;
    *(uint4*)dg = o.u[0]; *(uint4*)(dg + 8) = o.u[1];
  }
  if (tid < 128) {
    const int dir = tid >> 6, pp = tid & 63;
    const float glast = dir ? vec[192] : vec[128 + 63];
    const size_t vi = (size_t)dir * NTOK * 8 + ((size_t)n0 + pp) * 8 + h;
    P->geg[vi] = vec[256 + dir * 64 + pp];
    P->gks[vi] = __expf(glast - vec[128 + dir * 64 + pp]);
    if (pp == 0) P->ggl[dir * 1536 + item] = __expf(glast);
  }
  __syncthreads();
  if (tid < 128) gdn_dinv(M, Dv, tid);
  __syncthreads();
  gdn_solve_blocked(P, M, Dv, vec, kb, vb, tid, n0, h);
}

DI void attn_item(const bf16_t* __restrict__ Q, const bf16_t* __restrict__ Kp, const bf16_t* __restrict__ Vt, int vstride, int nA, int tb0, int tb1,
                  int qpos0, bool has_sink, float sinkv, bf16_t* __restrict__ Y, bf16_t* smb) {
  char* sm = (char*)smb;
  const int tid = tidx(), lane = tid & 63, wid = tid >> 6, lr = lane & 15, quad = lane >> 4;
  bf16x8 bq[2][2];
#pragma unroll
  for (int qt = 0; qt < 2; qt++)
#pragma unroll
    for (int ks = 0; ks < 2; ks++) bq[qt][ks] = *(const bf16x8*)(Q + (size_t)(wid * 32 + qt * 16 + lr) * 512 + ks * 32 + quad * 8);
  int offK[4][2], offV[4][2][2];
#pragma unroll
  for (int t = 0; t < 4; t++)
#pragma unroll
    for (int ks = 0; ks < 2; ks++) {
      offK[t][ks] = lds_byte(t * 16 + lr, ks * 32 + quad * 8);
      offV[t][ks][0] = 8192 + lds_byte(t * 16 + lr, ks * 32 + quad * 4);
      offV[t][ks][1] = 8192 + lds_byte(t * 16 + lr, ks * 32 + 16 + quad * 4);
    }
  f32x4 O[4][2];
#pragma unroll
  for (int dt = 0; dt < 4; dt++) { O[dt][0] = (f32x4){0.f, 0.f, 0.f, 0.f}; O[dt][1] = (f32x4){0.f, 0.f, 0.f, 0.f}; }
  float mrun[2];
  f32x4 lsum4[2];
  sinkv *= LOG2E;
  mrun[0] = mrun[1] = has_sink ? sinkv : -1e30f;
  lsum4[0] = lsum4[1] = (f32x4){0.f, 0.f, 0.f, 0.f};
  const int npairs = (nA + (tb1 - tb0)) >> 1, nAp = nA >> 1;
  __syncthreads();
  {
    const int t0 = (nAp > 0 ? 0 : tb0);
    stage_tile<64>(Kp + (size_t)t0 * 4096, 64, sm, tid);
    stage_tile<64>(Vt + t0 * 64, vstride, sm + 8192, tid);
    stage_tile<64>(Kp + (size_t)(t0 + 1) * 4096, 64, sm + 16384, tid);
    stage_tile<64>(Vt + (t0 + 1) * 64, vstride, sm + 24576, tid);
  }
  asm volatile("s_waitcnt vmcnt(0)" ::: "memory");
  __syncthreads();
  for (int ip = 0; ip < npairs; ip++) {
    const bool masked = ip >= nAp;
    const int tile0 = masked ? tb0 + 2 * (ip - nAp) : 2 * ip;
    const int cur = ip & 1;
    if (ip + 1 < npairs) {
      const int tn = (ip + 1 >= nAp) ? tb0 + 2 * (ip + 1 - nAp) : 2 * (ip + 1);
      char* nb = sm + (cur ^ 1) * 32768;
      stage_tile<64>(Kp + (size_t)tn * 4096, 64, nb, tid);
      stage_tile<64>(Vt + tn * 64, vstride, nb + 8192, tid);
      stage_tile<64>(Kp + (size_t)(tn + 1) * 4096, 64, nb + 16384, tid);
      stage_tile<64>(Vt + (tn + 1) * 64, vstride, nb + 24576, tid);
    }
#pragma unroll 1
    for (int sub = 0; sub < 2; sub++) {
    const int p0 = (tile0 + sub) * 64;
    const char* cb = sm + cur * 32768 + sub * 16384;
    f32x4 s[4][2];
    __builtin_amdgcn_s_setprio(1);
#pragma unroll
    for (int kt = 0; kt < 4; kt++) {
      const bf16x8 a0 = *(const bf16x8*)(cb + offK[kt][0]);
      const bf16x8 a1 = *(const bf16x8*)(cb + offK[kt][1]);
#pragma unroll
      for (int qt = 0; qt < 2; qt++) {
        f32x4 t = MFMA16(a0, bq[qt][0], ((f32x4){0.f, 0.f, 0.f, 0.f}));
        s[kt][qt] = MFMA16(a1, bq[qt][1], t);
      }
    }
    __builtin_amdgcn_s_setprio(0);
    if (masked) {
#pragma unroll
      for (int kt = 0; kt < 4; kt++)
#pragma unroll
        for (int qt = 0; qt < 2; qt++)
#pragma unroll
          for (int j = 0; j < 4; j++) {
            const int key = p0 + kt * 16 + quad * 4 + j;
            const int qp = qpos0 + wid * 32 + qt * 16 + lr;
            const int d = key - qp;
            if (d > 128 || d < -128) s[kt][qt][j] = -1e30f;
          }
    }
    float mx[2];
#pragma unroll
    for (int qt = 0; qt < 2; qt++) {
      const f32x4 m01 = __builtin_elementwise_max(s[0][qt], s[1][qt]);
      const f32x4 m23 = __builtin_elementwise_max(s[2][qt], s[3][qt]);
      const f32x4 m4 = __builtin_elementwise_max(m01, m23);
      float m = fmaxf(fmaxf(m4[0], m4[1]), fmaxf(m4[2], m4[3]));
      m = fmaxf(m, __shfl_xor(m, 16));
      m = fmaxf(m, __shfl_xor(m, 32));
      mx[qt] = m;
    }
    if (__any((mx[0] > mrun[0] + 8.f) || (mx[1] > mrun[1] + 8.f))) {
#pragma unroll
      for (int qt = 0; qt < 2; qt++) {
        const float mnew = fmaxf(mrun[qt], mx[qt]);
        const float alpha = __builtin_amdgcn_exp2f(mrun[qt] - mnew);
        mrun[qt] = mnew;
        lsum4[qt] *= alpha;
#pragma unroll
        for (int dt = 0; dt < 4; dt++) O[dt][qt] *= alpha;
      }
    }
#pragma unroll
    for (int qt = 0; qt < 2; qt++) {
      const float mr = mrun[qt];
#pragma unroll
      for (int kt = 0; kt < 4; kt++) {
        const f32x4 d = s[kt][qt] - mr;
        f32x4 pv;
        pv[0] = __builtin_amdgcn_exp2f(d[0]); pv[1] = __builtin_amdgcn_exp2f(d[1]); pv[2] = __builtin_amdgcn_exp2f(d[2]); pv[3] = __builtin_amdgcn_exp2f(d[3]);
        s[kt][qt] = pv;
        lsum4[qt] += pv;
      }
    }
    __builtin_amdgcn_s_setprio(1);
#pragma unroll
    for (int kk = 0; kk < 2; kk++) {
      bf16x8 bp[2];
#pragma unroll
      for (int qt = 0; qt < 2; qt++) {
        bp[qt] = pack8(s[2 * kk][qt][0], s[2 * kk][qt][1], s[2 * kk][qt][2], s[2 * kk][qt][3],
                       s[2 * kk + 1][qt][0], s[2 * kk + 1][qt][1], s[2 * kk + 1][qt][2], s[2 * kk + 1][qt][3]);
      }
#pragma unroll
      for (int dt = 0; dt < 4; dt++) {
        const bf16x4 v0 = *(const bf16x4*)(cb + offV[dt][kk][0]);
        const bf16x4 v1 = *(const bf16x4*)(cb + offV[dt][kk][1]);
        const bf16x8 av = __builtin_shufflevector(v0, v1, 0, 1, 2, 3, 4, 5, 6, 7);
#pragma unroll
        for (int qt = 0; qt < 2; qt++) O[dt][qt] = MFMA16(av, bp[qt], O[dt][qt]);
      }
    }
    __builtin_amdgcn_s_setprio(0);
    }
    asm volatile("s_waitcnt vmcnt(0)" ::: "memory");
    __syncthreads();
  }
#pragma unroll
  for (int qt = 0; qt < 2; qt++) {
    float lt = (lsum4[qt][0] + lsum4[qt][1]) + (lsum4[qt][2] + lsum4[qt][3]);
    lt += __shfl_xor(lt, 16);
    lt += __shfl_xor(lt, 32);
    if (has_sink) lt += __builtin_amdgcn_exp2f(sinkv - mrun[qt]);
    const float inv = 1.f / lt;
    bf16_t* yr = Y + (size_t)(wid * 32 + qt * 16 + lr) * 512;
#pragma unroll
    for (int dt = 0; dt < 4; dt++) {
      uint2 o;
      o.x = pack2(O[dt][qt][0] * inv, O[dt][qt][1] * inv);
      o.y = pack2(O[dt][qt][2] * inv, O[dt][qt][3] * inv);
      *(uint2*)(yr + dt * 16 + quad * 4) = o;
    }
  }
}

DI bf16x8 frag_perm(const bf16_t* base, int row, int kk, int quad) {
  const bf16_t* p = base + row * 72 + kk * 32 + quad * 4;
  const bf16x4 v0 = *(const bf16x4*)p;
  const bf16x4 v1 = *(const bf16x4*)(p + 16);
  return __builtin_shufflevector(v0, v1, 0, 1, 2, 3, 4, 5, 6, 7);
}
DI bf16x8 pack_c2(const f32x4& a, const f32x4& b) { return pack8(a[0], a[1], a[2], a[3], b[0], b[1], b[2], b[3]); }

DI void gdn_scan_item(CP P, int l, int seq, int h, int dir, char* smem) {
  const int tid = tidx(), lane = tid & 63, wid = tid >> 6, lr = lane & 15, quad = lane >> 4;
  const bool ctx = seq < 16;
  const int nch = ctx ? 4 : 64;
  const int n0 = ctx ? seq * 256 : NCTX + (seq - 16) * 4096;
  const int ch0 = n0 >> 6;
  bf16_t* sQ = (bf16_t*)smem;
  bf16_t* sKT = sQ + 4608;
  bf16_t* sW = sKT + 4608;
  bf16_t* sA = sW + 4608;
  bf16_t* sU = sA + 4608;
  float* sEg = (float*)(smem + 46080);
  float* sKs = sEg + 64;
  float* sGl = sKs + 64;
  f32x4 S[4];
  if (ctx) {
#pragma unroll
    for (int mi = 0; mi < 4; mi++) S[mi] = (f32x4){0.f, 0.f, 0.f, 0.f};
  } else {
    const float* src = P->state + ((((size_t)(seq - 16) * 4 + l) * 2 + dir) * 8 + h) * 4096;
#pragma unroll
    for (int mi = 0; mi < 4; mi++)
#pragma unroll
      for (int j = 0; j < 4; j++) S[mi][j] = src[(mi * 16 + quad * 4 + j) * 64 + wid * 16 + lr];
  }
  const size_t doff = (size_t)dir * NTOK * 512;
  uint4 pq0, pq1, pk0, pk1, pw0, pw1, pa0, pa1, pu0, pu1;
  float pv = 0.f;
  const int lrow = tid >> 3, lcol = (tid & 7) * 8;
#define GDN_ISSUE1(i_, Q_, K_, W_, A_, U_) { \
      const size_t ro = tb + (size_t)(lrow + 32 * (i_)) * 512 + lcol; \
      Q_ = *(const uint4*)(P->gq + ro); \
      K_ = *(const uint4*)(P->gkT + ((size_t)((ch0 + c__) * 8 + h) * 64 + lrow + 32 * (i_)) * 64 + lcol); \
      W_ = *(const uint4*)(P->gw + doff + ro); \
      A_ = *(const uint4*)(P->gattn + doff + ro); \
      U_ = *(const uint4*)(P->gu + doff + ro); }
#define GDN_ISSUE(c_) do { const int c__ = (c_); \
    const size_t tb = ((size_t)n0 + c__ * 64) * 512 + h * 64; \
    GDN_ISSUE1(0, pq0, pk0, pw0, pa0, pu0) \
    GDN_ISSUE1(1, pq1, pk1, pw1, pa1, pu1) \
    if (tid < 64) pv = P->geg[(size_t)dir * NTOK * 8 + ((size_t)n0 + c__ * 64 + tid) * 8 + h]; \
    else if (tid < 128) pv = P->gks[(size_t)dir * NTOK * 8 + ((size_t)n0 + c__ * 64 + tid - 64) * 8 + h]; \
    else if (tid == 128) pv = P->ggl[dir * 1536 + (ch0 + c__) * 8 + h]; \
  } while (0)
  GDN_ISSUE(dir ? nch - 1 : 0);
  for (int cc = 0; cc < nch; cc++) {
    const int c = dir ? nch - 1 - cc : cc;
    __syncthreads();
    {
      const int so0 = lrow * 72 + lcol, so1 = (lrow + 32) * 72 + lcol;
      *(uint4*)(sQ + so0) = pq0; *(uint4*)(sQ + so1) = pq1;
      *(uint4*)(sKT + so0) = pk0; *(uint4*)(sKT + so1) = pk1;
      *(uint4*)(sW + so0) = pw0; *(uint4*)(sW + so1) = pw1;
      *(uint4*)(sA + so0) = pa0; *(uint4*)(sA + so1) = pa1;
      *(uint4*)(sU + so0) = pu0; *(uint4*)(sU + so1) = pu1;
    }
    if (tid < 64) sEg[tid] = pv; else if (tid < 128) sKs[tid - 64] = pv; else if (tid == 128) sGl[0] = pv;
    __syncthreads();
    if (cc + 1 < nch) GDN_ISSUE(dir ? nch - 2 - cc : cc + 1);
    bf16x8 sB[2];
    sB[0] = pack_c2(S[0], S[1]);
    sB[1] = pack_c2(S[2], S[3]);
    f32x4 U[4], QS[4];
#pragma unroll
    for (int mi = 0; mi < 4; mi++) {
      f32x4 aw = (f32x4){0.f, 0.f, 0.f, 0.f}, aq = (f32x4){0.f, 0.f, 0.f, 0.f};
#pragma unroll
      for (int kk = 0; kk < 2; kk++) {
        aw = MFMA16(frag_perm(sW, mi * 16 + lr, kk, quad), sB[kk], aw);
        aq = MFMA16(frag_perm(sQ, mi * 16 + lr, kk, quad), sB[kk], aq);
      }
#pragma unroll
      for (int j = 0; j < 4; j++) U[mi][j] = bf2f(sU[(mi * 16 + quad * 4 + j) * 72 + wid * 16 + lr]) - aw[j];
      QS[mi] = aq;
    }
    bf16x8 uB[2], usB[2];
    {
      f32x4 t[4];
#pragma unroll
      for (int mi = 0; mi < 4; mi++)
#pragma unroll
        for (int j = 0; j < 4; j++) t[mi][j] = U[mi][j] * sKs[mi * 16 + quad * 4 + j];
      uB[0] = pack_c2(U[0], U[1]); uB[1] = pack_c2(U[2], U[3]);
      usB[0] = pack_c2(t[0], t[1]); usB[1] = pack_c2(t[2], t[3]);
    }
    bf16_t* og = P->obf + doff + ((size_t)n0 + c * 64) * 512 + h * 64 + wid * 16 + lr;
#pragma unroll
    for (int mi = 0; mi < 4; mi++) {
      f32x4 aa = (f32x4){0.f, 0.f, 0.f, 0.f};
#pragma unroll
      for (int kk = 0; kk < 2; kk++) aa = MFMA16(frag_perm(sA, mi * 16 + lr, kk, quad), uB[kk], aa);
#pragma unroll
      for (int j = 0; j < 4; j++) {
        const int pr = mi * 16 + quad * 4 + j;
        og[(size_t)pr * 512] = f2bf(sEg[pr] * QS[mi][j] + aa[j]);
      }
    }
    const float gl = sGl[0];
#pragma unroll
    for (int mi = 0; mi < 4; mi++) {
      f32x4 ak = (f32x4){0.f, 0.f, 0.f, 0.f};
#pragma unroll
      for (int kk = 0; kk < 2; kk++) ak = MFMA16(frag_perm(sKT, mi * 16 + lr, kk, quad), usB[kk], ak);
#pragma unroll
      for (int j = 0; j < 4; j++) S[mi][j] = gl * S[mi][j] + ak[j];
    }
  }
  if (ctx) {
    float* dst = P->out + OUT_ST + ((((size_t)seq * 4 + l) * 2 + dir) * 8 + h) * 4096;
#pragma unroll
    for (int mi = 0; mi < 4; mi++)
#pragma unroll
      for (int j = 0; j < 4; j++) dst[(mi * 16 + quad * 4 + j) * 64 + wid * 16 + lr] = S[mi][j];
  }
}

constexpr int MIX_GL = 32, MIX_BL = 512, MIX_CL = 512, MIX_GC = 256, MIX_BC = 256, MIX_CC = 256;
constexpr int MIX_N = MIX_GL + MIX_BL + MIX_CL + MIX_GC + MIX_BC + MIX_CC;

DI void mix_item(CP P, int l, int item, char* smem) {
  if (item < MIX_GL) { gdn_scan_item(P, l, 16 + (item >> 4), (item >> 1) & 7, item & 1, smem); return; }
  item -= MIX_GL;
  if (item < MIX_BL + MIX_CL) {
    const int typeC = item >= MIX_BL;
    const int i = typeC ? item - MIX_BL : item;
    const int b = i >> 8, head = (i >> 5) & 7, qb = i & 31, kvh = head >> 2;
    const size_t tok0 = (size_t)NCTX + b * 4096 + qb * 128;
    const bf16_t* Q = (typeC ? P->qC : P->qB) + tok0 * 512 + head * 64;
    const bf16_t* Kp = (typeC ? P->kfC : P->kfB) + (size_t)(b * 2 + kvh) * LFULL * 64;
    const bf16_t* Vt = (typeC ? P->vtfC : P->vtfB) + (size_t)(b * 2 + kvh) * 64 * LFULL;
    bf16_t* Y = (typeC ? P->yc : P->yb) + tok0 * 512 + head * 64;
    if (!typeC) {
      attn_item(Q, Kp, Vt, LFULL, 72, 0, 0, 0, false, 0.f, Y, (bf16_t*)smem);
    } else {
      const int start = qb * 128;
      const int lo = start - 128 < 0 ? 0 : start - 128;
      const int hi = start + 256 > 4096 ? 4096 : start + 256;
      attn_item(Q, Kp, Vt, LFULL, 8, (512 + lo) >> 6, (512 + hi) >> 6, 512 + start, true, P->sink[l * 8 + head], Y, (bf16_t*)smem);
    }
    return;
  }
  item -= MIX_BL + MIX_CL;
  if (item < MIX_GC) { gdn_scan_item(P, l, item >> 4, (item >> 1) & 7, item & 1, smem); return; }
  item -= MIX_GC;
  {
    const int typeC = item >= MIX_BC;
    const int i = typeC ? item - MIX_BC : item;
    const int b = i >> 4, head = (i >> 1) & 7, qb = i & 1, kvh = head >> 2;
    const size_t tok0 = (size_t)b * 256 + qb * 128;
    const bf16_t* Q = (typeC ? P->qC : P->qB) + tok0 * 512 + head * 64;
    const bf16_t* Kp = (typeC ? P->kcC : P->kcB) + (size_t)(b * 2 + kvh) * 256 * 64;
    const bf16_t* Vt = (typeC ? P->vtcC : P->vtcB) + (size_t)(b * 2 + kvh) * 64 * 256;
    bf16_t* Y = (typeC ? P->yc : P->yb) + tok0 * 512 + head * 64;
    attn_item(Q, Kp, Vt, 256, 4, 0, 0, 0, typeC != 0, typeC ? P->sink[l * 8 + head] : 0.f, Y, (bf16_t*)smem);
  }
}

constexpr int GDNOUT_N = NTOK / 4;
DI void gdnout_item(CP P, int l, int item) {
  const int tid = tidx(), lane = tid & 63, wid = tid >> 6;
  const size_t base = (size_t)(item * 4 + wid) * 512 + lane;
  float o[8], zz[8];
#pragma unroll
  for (int hh = 0; hh < 8; hh++) {
    const size_t idx = base + hh * 64;
    o[hh] = bf2f(P->obf[idx]) + bf2f(P->obf[(size_t)NTOK * 512 + idx]);
    zz[hh] = bf2f(P->z[idx]);
  }
  const float an = P->a_norm[l * 64 + lane];
#pragma unroll
  for (int hh = 0; hh < 8; hh++) {
    const float ss = wave_sum(o[hh] * o[hh]);
    const float on = o[hh] * rsqrtf(ss * (1.f / 64.f) + EPS) * an;
    P->ya[base + hh * 64] = f2bf(on * siluf_(zz[hh]));
  }
}

#define XB_TMO      128
#define XB_XCNT(j)  (256  + 64 * (j))
#define XB_XSUB(j)  (1280 + 64 * (j))
#define XB_XGEN(j)  (2304 + 64 * (j))
#define XB_TOP      3328
#define XB_TOPGEN   3392
#define XCD_BAR_WORDS 3456
#define XB_SPIN_CAP (1u << 22)
#define LAS __attribute__((address_space(3)))
DI unsigned xb_ld(unsigned* p) { return __hip_atomic_load(p, __ATOMIC_RELAXED, __HIP_MEMORY_SCOPE_AGENT); }
DI unsigned xb_add(unsigned* p, unsigned v) { return __hip_atomic_fetch_add(p, v, __ATOMIC_RELAXED, __HIP_MEMORY_SCOPE_AGENT); }
DI unsigned xb_xcc_id() { return (unsigned)__builtin_amdgcn_s_getreg((3 << 11) | 20) & 0xFu; }
#define XB_SPIN(cond, bar) do { unsigned _sp = 0; while (cond) { __builtin_amdgcn_s_sleep(1); \
    if ((++_sp & 255u) == 0u) { if (xb_ld(&(bar)[XB_TMO])) break; if (_sp > XB_SPIN_CAP) { atomicAdd(&(bar)[XB_TMO], 1u); break; } } } } while (0)
struct XcdBarrier { unsigned* bar; unsigned x; volatile LAS unsigned* st; };
DI XcdBarrier xcd_barrier_post(unsigned* bar, volatile LAS unsigned* st) {
  XcdBarrier b; b.bar = bar; b.x = xb_xcc_id(); b.st = st;
  if (threadIdx.x == 0) (void)xb_add(&bar[XB_XCNT(b.x)], 1u);
  return b;
}
DI void xcd_barrier_complete(unsigned* bar, unsigned x, unsigned& nloc, unsigned& nx) {
  const unsigned G = gridDim.x * gridDim.y * gridDim.z;
  unsigned sum, cnt, mine, sp = 0u;
  for (;;) {
    sum = 0u; cnt = 0u; mine = 0u;
#pragma unroll
    for (unsigned j = 0; j < 16; ++j) { const unsigned c = xb_ld(&bar[XB_XCNT(j)]); sum += c; cnt += (c > 0u) ? 1u : 0u; mine = (j == x) ? c : mine; }
    if (sum == G) break;
    __builtin_amdgcn_s_sleep(1);
    if ((++sp & 255u) == 0u) { if (xb_ld(&bar[XB_TMO])) break; if (sp > XB_SPIN_CAP) { atomicAdd(&bar[XB_TMO], 1u); break; } }
  }
  nloc = mine > 0u ? mine : 1u; nx = cnt > 0u ? cnt : 1u;
}
DI void xcd_barrier(const XcdBarrier& b) {
  asm volatile("s_waitcnt vmcnt(0)" ::: "memory");
  __syncthreads();
  if (threadIdx.x == 0) {
    unsigned* bar = b.bar;
    __builtin_amdgcn_s_waitcnt(0);
    unsigned nloc = b.st[0], nx = b.st[1];
    if (nloc == 0u) { xcd_barrier_complete(bar, b.x, nloc, nx); b.st[0] = nloc; b.st[1] = nx; }
    const unsigned old = xb_add(&bar[XB_XSUB(b.x)], 1u);
    const unsigned gen = old / nloc;
    if (old + 1u == (gen + 1u) * nloc) {
      __builtin_amdgcn_fence(__ATOMIC_RELEASE, "agent");
      asm volatile("s_waitcnt vmcnt(0)" ::: "memory");
      const unsigned og = xb_add(&bar[XB_TOP], 1u);
      const unsigned tg = og / nx;
      if (og + 1u == (tg + 1u) * nx) xb_add(&bar[XB_TOPGEN], 1u);
      else XB_SPIN(xb_ld(&bar[XB_TOPGEN]) == tg, bar);
      __builtin_amdgcn_fence(__ATOMIC_ACQUIRE, "agent");
      xb_add(&bar[XB_XGEN(b.x)], 1u);
      asm volatile("s_waitcnt vmcnt(0)" ::: "memory");
    } else {
      XB_SPIN(xb_ld(&bar[XB_XGEN(b.x)]) == gen, bar);
      __builtin_amdgcn_fence(__ATOMIC_ACQUIRE, "agent");
      asm volatile("s_waitcnt vmcnt(0)" ::: "memory");
    }
  }
  __syncthreads();
}

enum { PH_PREP = 0, PH_NORM1, PH_GEMM_IN, PH_FEAT, PH_MIX, PH_GDNOUT, PH_GEMM_BR, PH_GEMM_O, PH_NORM2, PH_FF1, PH_FF2, PH_COUNT };

__host__ __device__ inline int phase_count(int ph) {
  switch (ph) {
    case PH_PREP: return PREP_N;
    case PH_NORM1: return NORM1_N;
    case PH_GEMM_IN: return GEMM_IN_N;
    case PH_FEAT: return GDNA_N;
    case PH_MIX: return MIX_N;
    case PH_GDNOUT: return GDNOUT_N;
    case PH_GEMM_BR: return GEMM_BR_N;
    case PH_GEMM_O: return GEMM_FF2R_N;
    case PH_NORM2: return NORM_ROWS;
    case PH_FF1: return GEMM_FF1_N;
    case PH_FF2: return GEMM_FF2R_N;
  }
  return 0;
}

DI void run_item(CP P, int ph, int l, int item, char* smem) {
  switch (ph) {
    case PH_PREP: prep_item(P, item, smem); break;
    case PH_NORM1: if (item < NORM_ROWS) modnorm_item(P, l, 0, item); else cache_item(P, l, item - NORM_ROWS); break;
    case PH_GEMM_IN: gemm_in_item(P, l, item, smem); break;
    case PH_FEAT: gdn_a_item(P, l, item, smem); break;
    case PH_MIX: mix_item(P, l, item, smem); break;
    case PH_GDNOUT: gdnout_item(P, l, item); break;
    case PH_GEMM_BR: gemm_br_item(P, l, item, smem); break;
    case PH_GEMM_O: gemm_res_ring_item(P, l, item, smem, P->h, 1024, P->wt_o + (size_t)l * 1024 * 1024, 2048); break;
    case PH_NORM2: modnorm_item(P, l, 1, item); break;
    case PH_FF1: gemm_ff1_item(P, l, item, smem); break;
    case PH_FF2: gemm_res_ring_item(P, l, item, smem, P->f, 4096, P->wt_ff2 + (size_t)l * 1024 * 4096, 5120); break;
  }
}

#if !MEGA
template <int PH>
__global__ void __launch_bounds__(256, 2) k_phase(Params Pk, int l) {
  __shared__ __attribute__((aligned(16))) char smem[SMEM_BYTES];
  CP P = launder_params();
  const int n = phase_count(PH);
  for (int item = blockIdx.x; item < n; item += gridDim.x) run_item(P, PH, l, item, smem);
}
#else
template <int PH>
DI void phase_loop(int l, char* smem) {
  CP P = launder_params();
  const int n = phase_count(PH);
#pragma unroll 1
  for (int item = blockIdx.x; item < n; item += gridDim.x) run_item(P, PH, l, item, smem);
}

#ifndef PROBE_PH
#define PROBE_PH -1
#endif
#define GSYNC() xcd_barrier(xb)
#define RUNPH(PH_) do { phase_loop<PH_>(l, smem); GSYNC(); if (PROBE_PH == PH_) { phase_loop<PH_>(l, smem); GSYNC(); } } while (0)

DI void mix_loop(int l, unsigned* ctr, char* smem, int* s_item) {
  CP P = launder_params();
#pragma unroll 1
  for (;;) {
    __syncthreads();
    if (threadIdx.x == 0) *s_item = (int)atomicAdd(ctr, 1u);
    __syncthreads();
    const int item = *s_item;
    if (item >= MIX_N) break;
    run_item(P, PH_MIX, l, item, smem);
  }
}

__global__ void __launch_bounds__(256, 2) k_mega(Params Pk) {
  __shared__ __attribute__((aligned(16))) char smem[SMEM_BYTES];
  __shared__ uint4 xb_words;
  __shared__ int s_item;
  cg::grid_group grid = cg::this_grid();
  if (threadIdx.x == 0) xb_words = make_uint4(0u, 0u, 0u, 0u);
  __syncthreads();
  const XcdBarrier xb = xcd_barrier_post(launder_params()->bar, (volatile LAS unsigned*)&xb_words);
  phase_loop<PH_PREP>(0, smem);
  if (launder_params()->never) grid.sync();
  GSYNC();
  if (PROBE_PH == PH_PREP) { phase_loop<PH_PREP>(0, smem); GSYNC(); }
#pragma unroll 1
  for (int l = 0; l < 4; l++) {
    RUNPH(PH_NORM1);
    RUNPH(PH_GEMM_IN);
    RUNPH(PH_FEAT);
    mix_loop(l, launder_params()->counters + l, smem, &s_item);
    GSYNC();
    if (PROBE_PH == PH_MIX) { mix_loop(l, launder_params()->counters + 8 + l, smem, &s_item); GSYNC(); }
    RUNPH(PH_GDNOUT);
    RUNPH(PH_GEMM_BR);
    phase_loop<PH_GEMM_O>(l, smem); GSYNC();
    RUNPH(PH_NORM2);
    RUNPH(PH_FF1);
    phase_loop<PH_FF2>(l, smem); GSYNC();
  }
}
#endif

static inline size_t align_up(size_t x) { return (x + 255) & ~(size_t)255; }

extern "C" void kernel_launch(void* const* d_in, const int* in_sizes, int n_in, void* d_out, int out_size, void* d_ws, size_t ws_size, hipStream_t stream) {
  Params P;
  memset(&P, 0, sizeof(P));
  P.x_prompt = (const float*)d_in[0]; P.x_sample = (const float*)d_in[1];
  P.ckg = (const float*)d_in[2]; P.cvg = (const float*)d_in[3]; P.ckw = (const float*)d_in[4]; P.cvw = (const float*)d_in[5];
  P.state = (const float*)d_in[6]; P.c = (const float*)d_in[7]; P.c_ctx = (const float*)d_in[8];
  P.w_mod = (const float*)d_in[9]; P.b_mod = (const float*)d_in[10]; P.ln1 = (const float*)d_in[11]; P.ln2 = (const float*)d_in[12];
  P.w_in = (const float*)d_in[13]; P.conv = (const float*)d_in[14]; P.a_log = (const float*)d_in[15]; P.dt_bias = (const float*)d_in[16];
  P.a_norm = (const float*)d_in[17]; P.qk_norm = (const float*)d_in[18]; P.sink = (const float*)d_in[19];
  P.w_br_a = (const float*)d_in[20]; P.w_br_b = (const float*)d_in[21]; P.w_br_c = (const float*)d_in[22];
  P.w_o = (const float*)d_in[23]; P.w_ff1 = (const float*)d_in[24]; P.w_ff2 = (const float*)d_in[25];
  P.out = (float*)d_out;
  char* ws = (char*)d_ws;
  size_t off = 0;
  auto take = [&](size_t bytes) { char* p = ws + off; off = align_up(off + bytes); return p; };
  P.wt_in = (bf16_t*)take((size_t)4 * NCOLP * 1024 * 2);
  P.wt_br = (bf16_t*)take((size_t)4 * 3 * 1024 * 512 * 2);
  P.wt_o = (bf16_t*)take((size_t)4 * 1024 * 1024 * 2);
  P.wt_ff1 = (bf16_t*)take((size_t)4 * 4096 * 1024 * 2);
  P.wt_ff2 = (bf16_t*)take((size_t)4 * 4096 * 1024 * 2);
  P.mods = (float*)take((size_t)4 * 3 * 6144 * 4);
  P.ropec = (float*)take((size_t)4096 * 32 * 4);
  P.ropes = (float*)take((size_t)4096 * 32 * 4);
  P.counters = (unsigned*)take(1024);
  P.bar = (unsigned*)take((size_t)XCD_BAR_WORDS * 4);
  P.h = (bf16_t*)take((size_t)NTOK * DM * 2);
  P.kfB = (bf16_t*)take((size_t)4 * LFULL * 64 * 2);
  P.vtfB = (bf16_t*)take((size_t)4 * LFULL * 64 * 2);
  P.kfC = (bf16_t*)take((size_t)4 * LFULL * 64 * 2);
  P.vtfC = (bf16_t*)take((size_t)4 * LFULL * 64 * 2);
  P.kcB = (bf16_t*)take((size_t)32 * 256 * 64 * 2);
  P.vtcB = (bf16_t*)take((size_t)32 * 256 * 64 * 2);
  P.kcC = (bf16_t*)take((size_t)32 * 256 * 64 * 2);
  P.vtcC = (bf16_t*)take((size_t)32 * 256 * 64 * 2);
  P.ba = (float*)take((size_t)NTOK * 32 * 4);
  P.bg = (float*)take((size_t)NTOK * 32 * 4);
  P.yb = (bf16_t*)take((size_t)NTOK * 512 * 2);
  P.yc = (bf16_t*)take((size_t)NTOK * 512 * 2);
  P.qC = (bf16_t*)take((size_t)NTOK * 512 * 2);
  char* fregion = take((size_t)NTOK * DFF * 2);
  P.f = (bf16_t*)fregion;
  P.gates = (bf16_t*)fregion;
  P.z = (bf16_t*)(fregion + (size_t)NTOK * 3072 * 2);
  P.qB = (bf16_t*)(fregion + (size_t)NTOK * 3072 * 2 + (size_t)NTOK * 512 * 2);
  P.gq = (bf16_t*)take((size_t)NTOK * 512 * 2);
  P.gkT = (bf16_t*)take((size_t)NTOK * 512 * 2);
  P.gw = (bf16_t*)take((size_t)2 * NTOK * 512 * 2);
  P.gu = (bf16_t*)take((size_t)2 * NTOK * 512 * 2);
  P.gattn = P.h;
  P.geg = (float*)take((size_t)2 * NTOK * 8 * 4);
  P.gks = (float*)take((size_t)2 * NTOK * 8 * 4);
  P.ggl = (float*)take((size_t)2 * 1536 * 4);
  P.ya = P.gq;
  char* oregion = take((size_t)NTOK * 1536 * 2);
  P.obf = (bf16_t*)oregion;
  P.qkv_raw = (bf16_t*)oregion;
  if (off > ws_size) { fprintf(stderr, "workspace too small: need %zu have %zu\n", off, ws_size); return; }

#if !MEGA
#define LAUNCH(PH, l) hipLaunchKernelGGL(k_phase<PH>, dim3(phase_count(PH) < 8192 ? phase_count(PH) : 8192), dim3(256), 0, stream, P, l)
  LAUNCH(PH_PREP, 0);
  for (int l = 0; l < 4; l++) {
    LAUNCH(PH_NORM1, l); LAUNCH(PH_GEMM_IN, l); LAUNCH(PH_FEAT, l); LAUNCH(PH_MIX, l); LAUNCH(PH_GDNOUT, l);
    LAUNCH(PH_GEMM_BR, l); LAUNCH(PH_GEMM_O, l); LAUNCH(PH_NORM2, l); LAUNCH(PH_FF1, l); LAUNCH(PH_FF2, l);
  }
#else
  static int grid_blocks = 0;
  if (!grid_blocks) {
    int dev = 0, cus = 0, per_cu = 0;
    hipGetDevice(&dev);
    hipDeviceGetAttribute(&cus, hipDeviceAttributeMultiprocessorCount, dev);
    hipOccupancyMaxActiveBlocksPerMultiprocessor(&per_cu, k_mega, 256, 0);
    if (per_cu > 2) per_cu = 2;
    grid_blocks = cus * per_cu;
  }
  hipMemsetAsync(P.bar, 0, (size_t)XCD_BAR_WORDS * 4, stream);
  void* args[] = {&P};
  hipError_t e = hipLaunchCooperativeKernel((void*)k_mega, dim3(grid_blocks), dim3(256), args, 0, stream);
  if (e != hipSuccess) fprintf(stderr, "cooperative launch failed: %s (grid %d)\n", hipGetErrorString(e), grid_blocks);
#endif
}
```

```cpp
#include <hip/hip_runtime.h>
#include <hip/hip_cooperative_groups.h>
#include <stdint.h>
#include <stdio.h>
#include <string.h>
namespace cg = cooperative_groups;

#ifndef MEGA
#define MEGA 1
#endif

typedef unsigned short bf16_t;
typedef __attribute__((ext_vector_type(8))) short bf16x8;
typedef __attribute__((ext_vector_type(4))) short bf16x4;
typedef __attribute__((ext_vector_type(4))) float f32x4;
#define DI __device__ __forceinline__
#define MFMA16(a, b, c) __builtin_amdgcn_mfma_f32_16x16x32_bf16((a), (b), (c), 0, 0, 0)

constexpr int NTOK = 12288, NCTX = 4096, DM = 1024, NCOLP = 6784, INCOLS = 6688, DFF = 4096;
constexpr int LFULL = 4608;
constexpr float EPS = 1e-6f;
constexpr float LOG2E = 1.4426950408889634f;
constexpr float QSCALE = 0.125f * LOG2E;
constexpr size_t OUT_KG = 12582912, OUT_VG = 14680064, OUT_KW = 16777216, OUT_VW = 18874368, OUT_ST = 20971520;
constexpr int SMEM_BYTES = 73728;

struct Params {
  const float *x_prompt, *x_sample, *ckg, *cvg, *ckw, *cvw, *state, *c, *c_ctx, *w_mod, *b_mod, *ln1, *ln2, *w_in, *conv,
      *a_log, *dt_bias, *a_norm, *qk_norm, *sink, *w_br_a, *w_br_b, *w_br_c, *w_o, *w_ff1, *w_ff2;
  float* out;
  bf16_t *wt_in, *wt_br, *wt_o, *wt_ff1, *wt_ff2;
  float *mods, *ropec, *ropes;
  unsigned* counters;
  unsigned* bar;
  long long never;
  bf16_t* h;
  bf16_t *qkv_raw, *z, *qB, *qC, *gates;
  float *ba, *bg;
  bf16_t *gq, *gkT, *gw, *gu, *gattn, *obf;
  float *geg, *gks, *ggl;
  bf16_t *kfB, *vtfB, *kfC, *vtfC;
  bf16_t *kcB, *vtcB, *kcC, *vtcC;
  bf16_t *ya, *yb, *yc;
  bf16_t* f;
};

typedef const __attribute__((address_space(4))) Params* CP;

DI CP launder_params() {
  CP cp = (CP)__builtin_amdgcn_kernarg_segment_ptr();
  asm volatile("" : "+s"(cp));
  return cp;
}

DI float bf2f(bf16_t x) { return __uint_as_float(((unsigned)x) << 16); }
DI unsigned pack2(float a, float b) { unsigned r; asm("v_cvt_pk_bf16_f32 %0, %1, %2" : "=v"(r) : "v"(a), "v"(b)); return r; }
DI bf16_t f2bf(float f) { unsigned u = __float_as_uint(f); u += 0x7fffu + ((u >> 16) & 1u); return (bf16_t)(u >> 16); }
typedef __attribute__((ext_vector_type(4))) unsigned u32x4_t;
DI bf16x8 pack8(float x0, float x1, float x2, float x3, float x4, float x5, float x6, float x7) {
  u32x4_t p;
  asm volatile("v_cvt_pk_bf16_f32 %0, %4, %5\n\tv_cvt_pk_bf16_f32 %1, %6, %7\n\tv_cvt_pk_bf16_f32 %2, %8, %9\n\tv_cvt_pk_bf16_f32 %3, %10, %11\n\ts_nop 1"
               : "=&v"(p[0]), "=&v"(p[1]), "=&v"(p[2]), "=&v"(p[3])
               : "v"(x0), "v"(x1), "v"(x2), "v"(x3), "v"(x4), "v"(x5), "v"(x6), "v"(x7));
  return __builtin_bit_cast(bf16x8, p);
}
DI int tidx() { int t = threadIdx.x; asm volatile("" : "+v"(t)); return t; }
DI float wave_sum(float v) {
#pragma unroll
  for (int o = 32; o > 0; o >>= 1) v += __shfl_xor(v, o);
  return v;
}
DI float sigmoidf_(float x) { return 1.f / (1.f + __expf(-x)); }
DI float siluf_(float x) { return x / (1.f + __expf(-x)); }
DI int mod_index(int n) { return n < NCTX ? 0 : 1 + ((n - NCTX) >> 12); }

constexpr int PREP_MODS = 384, PREP_TRL = 4384, PREP_TR = 4 * PREP_TRL, PREP_XC = 768, PREP_ROPE = 32, PREP_MISC = 1;
constexpr int PREP_N = PREP_MODS + PREP_TR + PREP_XC + PREP_ROPE + PREP_MISC;

DI void tr_tile(const float* __restrict__ src, int ldsrc, int srccol0, int nvalid, bf16_t* __restrict__ dst, int ldd, int n0, int k0, float* tile) {
  const int tid = tidx();
  {
    const int nn4 = (tid & 15) * 4;
#pragma unroll
    for (int i = 0; i < 4; i++) {
      const int kk = (tid >> 4) + 16 * i;
      float4 v = make_float4(0.f, 0.f, 0.f, 0.f);
      if (nn4 < nvalid) v = *(const float4*)(src + (size_t)(k0 + kk) * ldsrc + srccol0 + nn4);
      tile[kk * 65 + nn4 + 0] = v.x; tile[kk * 65 + nn4 + 1] = v.y; tile[kk * 65 + nn4 + 2] = v.z; tile[kk * 65 + nn4 + 3] = v.w;
    }
  }
  __syncthreads();
  {
    const int kk4 = (tid & 15) * 4;
#pragma unroll
    for (int i = 0; i < 4; i++) {
      const int nn = (tid >> 4) + 16 * i;
      uint2 o;
      o.x = pack2(tile[(kk4 + 0) * 65 + nn], tile[(kk4 + 1) * 65 + nn]);
      o.y = pack2(tile[(kk4 + 2) * 65 + nn], tile[(kk4 + 3) * 65 + nn]);
      *(uint2*)(dst + (size_t)(n0 + nn) * ldd + k0 + kk4) = o;
    }
  }
  __syncthreads();
}

DI void prep_item(CP P, int item, char* smem) {
  const int tid = tidx(), lane = tid & 63, wid = tid >> 6;
  float* sm = (float*)smem;
  if (item < PREP_MODS) {
    const int l = item / 96, jb = item % 96;
    float* ssil = sm;
    float* red = sm + 3072;
    for (int k = tid; k < 1024; k += 256) {
      ssil[k] = siluf_(P->c_ctx[k]);
      ssil[1024 + k] = siluf_(P->c[k]);
      ssil[2048 + k] = siluf_(P->c[1024 + k]);
    }
    __syncthreads();
    const float* W = P->w_mod + (size_t)l * 1024 * 6144 + jb * 64 + lane;
    float a0 = 0.f, a1 = 0.f, a2 = 0.f;
    const int kb = wid * 256;
#pragma unroll 1
    for (int k0 = 0; k0 < 256; k0 += 32) {
      float w[32];
#pragma unroll
      for (int u = 0; u < 32; u++) w[u] = W[(size_t)(kb + k0 + u) * 6144];
#pragma unroll
      for (int u = 0; u < 32; u++) { a0 += ssil[kb + k0 + u] * w[u]; a1 += ssil[1024 + kb + k0 + u] * w[u]; a2 += ssil[2048 + kb + k0 + u] * w[u]; }
    }
    red[(wid * 3 + 0) * 64 + lane] = a0; red[(wid * 3 + 1) * 64 + lane] = a1; red[(wid * 3 + 2) * 64 + lane] = a2;
    __syncthreads();
    if (tid < 192) {
      const int m = tid >> 6, jj = tid & 63;
      float s = 0.f;
      for (int w = 0; w < 4; w++) s += red[(w * 3 + m) * 64 + jj];
      P->mods[((size_t)l * 3 + m) * 6144 + jb * 64 + jj] = s + P->b_mod[(size_t)l * 6144 + jb * 64 + jj];
    }
    __syncthreads();
    return;
  }
  item -= PREP_MODS;
  if (item < PREP_TR) {
    const int l = item / PREP_TRL; int s = item % PREP_TRL;
    if (s < 1696) {
      const int nt = s / 16, kt = s % 16;
      int srccol0 = nt * 64, nvalid = 64;
      if (nt == 32) { srccol0 = 2048; nvalid = 32; } else if (nt > 32 && nt < 105) { srccol0 = nt * 64 - 32; } else if (nt >= 105) { nvalid = 0; srccol0 = 0; }
      tr_tile(P->w_in + (size_t)l * 1024 * INCOLS, INCOLS, srccol0, nvalid, P->wt_in + (size_t)l * NCOLP * 1024, 1024, nt * 64, kt * 64, sm);
      return;
    }
    s -= 1696;
    if (s < 384) {
      const int which = s / 128, r = s % 128, nt = r / 8, kt = r % 8;
      const float* src = (which == 0 ? P->w_br_a : which == 1 ? P->w_br_b : P->w_br_c) + (size_t)l * 512 * 1024;
      tr_tile(src, 1024, nt * 64, 64, P->wt_br + (size_t)(l * 3 + which) * 1024 * 512, 512, nt * 64, kt * 64, sm);
      return;
    }
    s -= 384;
    if (s < 256) {
      const int nt = s / 16, kt = s % 16;
      tr_tile(P->w_o + (size_t)l * 1024 * 1024, 1024, nt * 64, 64, P->wt_o + (size_t)l * 1024 * 1024, 1024, nt * 64, kt * 64, sm);
      return;
    }
    s -= 256;
    if (s < 1024) {
      const int nt = s / 16, kt = s % 16;
      tr_tile(P->w_ff1 + (size_t)l * 1024 * 4096, 4096, nt * 64, 64, P->wt_ff1 + (size_t)l * 4096 * 1024, 1024, nt * 64, kt * 64, sm);
      return;
    }
    s -= 1024;
    {
      const int nt = s / 64, kt = s % 64;
      tr_tile(P->w_ff2 + (size_t)l * 4096 * 1024, 1024, nt * 64, 64, P->wt_ff2 + (size_t)l * 1024 * 4096, 4096, nt * 64, kt * 64, sm);
      return;
    }
  }
  item -= PREP_TR;
  if (item < PREP_XC) {
    const size_t base = (size_t)item * 16384;
    const float4* src = (const float4*)(base < 4194304 ? P->x_prompt + base : P->x_sample + (base - 4194304));
    float4* dst = (float4*)(P->out + base);
#pragma unroll 4
    for (int i = 0; i < 16; i++) dst[tid + 256 * i] = src[tid + 256 * i];
    return;
  }
  item -= PREP_XC;
  if (item < PREP_ROPE) {
    for (int i = 0; i < 16; i++) {
      const int e = item * 4096 + tid + 256 * i;
      const int t = e >> 5, i2 = e & 31;
      const int pos = (i2 < 16) ? (t >> 6) : (t & 63);
      const int fi = i2 & 15;
      const float inv = exp2f(-(float)fi * (13.287712379549449f / 16.f));
      const float ang = (float)pos * inv;
      P->ropec[e] = cosf(ang);
      P->ropes[e] = sinf(ang);
    }
    return;
  }
  item -= PREP_ROPE;
  if (tid < 64) P->counters[tid] = 0u;
}

constexpr int NORM_ROWS = NTOK / 8;
constexpr int NORM1_N = NORM_ROWS + 512;

DI void modnorm_item(CP P, int l, int which, int item) {
  const int tid = tidx(), lane = tid & 63, wid = tid >> 6;
  const int nb = item * 8 + wid * 2;
  float4 v[2][4];
  float ss[2];
#pragma unroll
  for (int r = 0; r < 2; r++) {
    const float* xr = P->out + (size_t)(nb + r) * DM;
#pragma unroll
    for (int i = 0; i < 4; i++) v[r][i] = *(const float4*)(xr + lane * 4 + 256 * i);
  }
  const float* md = P->mods + ((size_t)l * 3 + mod_index(nb)) * 6144;
  const float* sh = md + (which ? 3072 : 0);
  const float* sc = md + (which ? 4096 : 1024);
  const float* lw = (which ? P->ln2 : P->ln1) + (size_t)l * DM;
  float4 w4[4], s4[4], h4[4];
#pragma unroll
  for (int i = 0; i < 4; i++) {
    const int c = lane * 4 + 256 * i;
    w4[i] = *(const float4*)(lw + c); s4[i] = *(const float4*)(sc + c); h4[i] = *(const float4*)(sh + c);
    w4[i].x *= 1.f + s4[i].x; w4[i].y *= 1.f + s4[i].y; w4[i].z *= 1.f + s4[i].z; w4[i].w *= 1.f + s4[i].w;
  }
#pragma unroll
  for (int r = 0; r < 2; r++) {
    float a = 0.f;
#pragma unroll
    for (int i = 0; i < 4; i++) a += v[r][i].x * v[r][i].x + v[r][i].y * v[r][i].y + v[r][i].z * v[r][i].z + v[r][i].w * v[r][i].w;
    ss[r] = wave_sum(a);
  }
#pragma unroll
  for (int r = 0; r < 2; r++) {
    const float rstd = rsqrtf(ss[r] * (1.f / 1024.f) + EPS);
#pragma unroll
    for (int i = 0; i < 4; i++) {
      const int c = lane * 4 + 256 * i;
      uint2 o;
      o.x = pack2(v[r][i].x * rstd * w4[i].x + h4[i].x, v[r][i].y * rstd * w4[i].y + h4[i].y);
      o.y = pack2(v[r][i].z * rstd * w4[i].z + h4[i].z, v[r][i].w * rstd * w4[i].w + h4[i].w);
      *(uint2*)(P->h + (size_t)(nb + r) * DM + c) = o;
    }
  }
}

DI void cache_item(CP P, int l, int item) {
  const int tid = tidx();
  const int type = item >> 8, b = (item >> 7) & 1, pg = item & 127;
  const float* ck = type ? P->ckw : P->ckg;
  const float* cv = type ? P->cvw : P->cvg;
  bf16_t* kf = type ? P->kfC : P->kfB;
  bf16_t* vtf = type ? P->vtfC : P->vtfB;
#pragma unroll
  for (int i = 0; i < 2; i++) {
    const int e = tid + 256 * i;
    const int pl = e >> 7, c = e & 127, kvh = c >> 6, d = c & 63;
    const int pos = pg * 4 + pl;
    const size_t si = ((((size_t)b * 4 + l) * 512 + pos) * 2 + kvh) * 64 + d;
    kf[((size_t)(b * 2 + kvh) * LFULL + pos) * 64 + d] = f2bf(ck[si]);
    vtf[((size_t)(b * 2 + kvh) * 64 + d) * LFULL + pos] = f2bf(cv[si]);
  }
}

DI int lds_byte(int r, int c) { const int st = (r >> 4) * 2 + (c >> 5), rr = r & 15, cc = c & 31, ob = rr * 64 + cc * 2; return st * 1024 + (ob ^ (((ob >> 9) & 1) << 5)); }
DI void stage_rc(int b, int& R, int& C) { const int st = b >> 10, sb = b & 1023, swz = sb ^ (((sb >> 9) & 1) << 5); R = (st >> 1) * 16 + (swz >> 6); C = (st & 1) * 32 + ((swz & 63) >> 1); }

template <int ROWS>
DI void stage_tile(const bf16_t* __restrict__ g, int ld, char* lds, int tid) {
#pragma unroll
  for (int i = 0; i < ROWS / 32; i++) {
    const int b = tid * 16 + i * 4096;
    int R, C;
    stage_rc(b, R, C);
    __builtin_amdgcn_global_load_lds((const unsigned*)(g + (size_t)R * ld + C), (unsigned*)(lds + b), 16, 0, 0);
  }
}

template <int NI>
DI void gemm_mainloop(const bf16_t* __restrict__ A, int lda, const bf16_t* __restrict__ Bt, int ldb, int K, int m0, int n0, bf16_t* smb, f32x4 (&acc)[4][NI]) {
  char* sm = (char*)smb;
  const int tid = tidx(), lane = tid & 63, wid = tid >> 6, wm = wid >> 1, wn = wid & 1, lr = lane & 15, quad = lane >> 4;
  const bf16_t* ga = A + (size_t)m0 * lda;
  const bf16_t* gb = Bt + (size_t)n0 * ldb;
  int offA[4][2], offB[NI][2];
#pragma unroll
  for (int ks = 0; ks < 2; ks++) {
#pragma unroll
    for (int mi = 0; mi < 4; mi++) offA[mi][ks] = lds_byte(wm * 64 + mi * 16 + lr, ks * 32 + quad * 8);
#pragma unroll
    for (int ni = 0; ni < NI; ni++) offB[ni][ks] = 16384 + lds_byte(wn * 16 * NI + ni * 16 + lr, ks * 32 + quad * 8);
  }
  __syncthreads();
  stage_tile<128>(ga, lda, sm, tid);
  stage_tile<32 * NI>(gb, ldb, sm + 16384, tid);
  asm volatile("s_waitcnt vmcnt(0)" ::: "memory");
  __syncthreads();
  const int nk = K >> 6;
  for (int kt = 0; kt < nk; kt++) {
    const int cur = kt & 1;
    if (kt + 1 < nk) {
      char* nb = sm + (cur ^ 1) * 32768;
      stage_tile<128>(ga + (kt + 1) * 64, lda, nb, tid);
      stage_tile<32 * NI>(gb + (kt + 1) * 64, ldb, nb + 16384, tid);
    }
    const char* cb = sm + cur * 32768;
#pragma unroll
    for (int ks = 0; ks < 2; ks++) {
      bf16x8 af[4], bfr[NI];
#pragma unroll
      for (int mi = 0; mi < 4; mi++) af[mi] = *(const bf16x8*)(cb + offA[mi][ks]);
#pragma unroll
      for (int ni = 0; ni < NI; ni++) bfr[ni] = *(const bf16x8*)(cb + offB[ni][ks]);
#pragma unroll
      for (int mi = 0; mi < 4; mi++)
#pragma unroll
        for (int ni = 0; ni < NI; ni++) acc[mi][ni] = MFMA16(af[mi], bfr[ni], acc[mi][ni]);
    }
    asm volatile("s_waitcnt vmcnt(0)" ::: "memory");
    __syncthreads();
  }
}

template <int MI, int NI>
DI void gemm_mainloop3(const bf16_t* __restrict__ A, int lda, const bf16_t* __restrict__ Bt, int ldb, int K, int m0, int n0, char* sm, f32x4 (&acc)[MI][NI]) {
  constexpr int A_BYTES = 32 * MI * 64, B_BYTES = 32 * NI * 64, STAGE = A_BYTES + B_BYTES;
  static_assert(3 * STAGE <= SMEM_BYTES, "LDS");
  const int tid = tidx(), lane = tid & 63, wid = tid >> 6, wm = wid >> 1, wn = wid & 1, lr = lane & 15, quad = lane >> 4;
  const int sb = (tid * 16) & 1023, swz = sb ^ (((sb >> 9) & 1) << 5), rr = swz >> 6, cc = (swz & 63) >> 1;
  const bf16_t* ga = A + (size_t)(m0 + wid * 16 + rr) * lda + cc;
  const bf16_t* gb = Bt + (size_t)(n0 + wid * 16 + rr) * ldb + cc;
  const int lane_off = (lr * 64 + quad * 16) ^ (((lr >> 3) & 1) << 5);
  const int offA = (wm * MI) * 1024 + lane_off, offB = A_BYTES + (wn * NI) * 1024 + lane_off;
#define G3_STAGE(buf_, kt_) do { char* d_ = sm + (buf_) * STAGE + tid * 16; const int ko_ = (kt_) * 32; \
    _Pragma("unroll") for (int i = 0; i < MI / 2; i++) __builtin_amdgcn_global_load_lds((const unsigned*)(ga + (size_t)(i * 64) * lda + ko_), (unsigned*)(d_ + i * 4096), 16, 0, 0); \
    _Pragma("unroll") for (int i = 0; i < NI / 2; i++) __builtin_amdgcn_global_load_lds((const unsigned*)(gb + (size_t)(i * 64) * ldb + ko_), (unsigned*)(d_ + A_BYTES + i * 4096), 16, 0, 0); \
  } while (0)
  const int nk = K >> 5;
  __syncthreads();
  G3_STAGE(0, 0);
  G3_STAGE(1, 1);
  int cur = 0;
  for (int kt = 0; kt < nk; kt++) {
    if (kt + 1 < nk) asm volatile("s_waitcnt vmcnt(%0)" ::"n"(MI / 2 + NI / 2) : "memory");
    else asm volatile("s_waitcnt vmcnt(0)" ::: "memory");
    __builtin_amdgcn_s_barrier();
    asm volatile("" ::: "memory");
    const char* cb = sm + cur * STAGE;
    bf16x8 af[MI], bfr[NI];
#pragma unroll
    for (int mi = 0; mi < MI; mi++) af[mi] = *(const bf16x8*)(cb + offA + mi * 1024);
#pragma unroll
    for (int ni = 0; ni < NI; ni++) bfr[ni] = *(const bf16x8*)(cb + offB + ni * 1024);
    if (kt + 2 < nk) { const int nb = cur >= 1 ? cur - 1 : 2; G3_STAGE(nb, kt + 2); }
#pragma unroll
    for (int mi = 0; mi < MI; mi++)
#pragma unroll
      for (int ni = 0; ni < NI; ni++) acc[mi][ni] = MFMA16(af[mi], bfr[ni], acc[mi][ni]);
    cur = cur == 2 ? 0 : cur + 1;
  }
#undef G3_STAGE
}

template <int MI, int NI>
DI void zero_acc2(f32x4 (&acc)[MI][NI]) {
#pragma unroll
  for (int i = 0; i < MI; i++)
#pragma unroll
    for (int j = 0; j < NI; j++) acc[i][j] = (f32x4){0.f, 0.f, 0.f, 0.f};
}

template <int NI>
DI void zero_acc(f32x4 (&acc)[4][NI]) {
#pragma unroll
  for (int i = 0; i < 4; i++)
#pragma unroll
    for (int j = 0; j < NI; j++) acc[i][j] = (f32x4){0.f, 0.f, 0.f, 0.f};
}

DI bool tile_map(int item, int MT, int NT, int& mt, int& nt) {
  const int r = item >> 9, within = item & 511, x = within & 7, q = within >> 3;
  const int patch = r * 8 + x, pmn = MT >> 3;
  mt = (patch % pmn) * 8 + (q & 7);
  nt = (patch / pmn) * 8 + (q >> 3);
  return nt < NT;
}

constexpr int GEMM_IN_N = 48 * 53;

DI void gemm_in_item(CP P, int l, int item, char* smem) {
  const int mt = item % 48, nt = item / 48;
  const int m0 = mt * 256, n0 = nt * 128;
  f32x4 acc[8][4];
  zero_acc2<8, 4>(acc);
  gemm_mainloop3<8, 4>(P->h, DM, P->wt_in + (size_t)l * NCOLP * 1024, 1024, 1024, m0, n0, smem, acc);
  const int tid = tidx(), lane = tid & 63, wid = tid >> 6, wm = wid >> 1, wn = wid & 1, lr = lane & 15, quad = lane >> 4;
  const int row0 = m0 + wm * 128, col0 = n0 + wn * 64;
  const int w64 = col0 >> 6;
  if (w64 < 24) {
#pragma unroll
    for (int mi = 0; mi < 8; mi++)
#pragma unroll
      for (int j = 0; j < 4; j++) {
        const size_t row = row0 + mi * 16 + quad * 4 + j;
#pragma unroll
        for (int ni = 0; ni < 4; ni++) P->qkv_raw[row * 1536 + w64 * 64 + ni * 16 + lr] = f2bf(acc[mi][ni][j]);
      }
  } else if (w64 < 32) {
#pragma unroll
    for (int mi = 0; mi < 8; mi++)
#pragma unroll
      for (int j = 0; j < 4; j++) {
        const size_t row = row0 + mi * 16 + quad * 4 + j;
#pragma unroll
        for (int ni = 0; ni < 4; ni++) P->z[row * 512 + (w64 - 24) * 64 + ni * 16 + lr] = f2bf(acc[mi][ni][j]);
      }
  } else if (w64 == 32) {
#pragma unroll
    for (int mi = 0; mi < 8; mi++)
#pragma unroll
      for (int j = 0; j < 4; j++) {
        const size_t row = row0 + mi * 16 + quad * 4 + j;
#pragma unroll
        for (int ni = 0; ni < 2; ni++) P->ba[row * 32 + ni * 16 + lr] = acc[mi][ni][j];
      }
  } else if (w64 < 57) {
    const int hidx = w64 - 33;
    const int typeC = hidx >= 12;
    const int hh = typeC ? hidx - 12 : hidx;
    const bool isq = hh < 8, isk = (hh == 8 || hh == 9), isv = hh >= 10;
    const int kvh = isk ? hh - 8 : (isv ? hh - 10 : 0);
    const bool latent = row0 >= NCTX;
    const float* qn = P->qk_norm + ((size_t)l * 4 + (typeC ? 2 : 0) + (isk ? 1 : 0)) * 64;
    float qw[4];
#pragma unroll
    for (int ni = 0; ni < 4; ni++) qw[ni] = qn[ni * 16 + lr];
#pragma unroll
    for (int mi = 0; mi < 8; mi++)
#pragma unroll
      for (int j = 0; j < 4; j++) {
        const int row = row0 + mi * 16 + quad * 4 + j;
        float val[4];
#pragma unroll
        for (int ni = 0; ni < 4; ni++) val[ni] = acc[mi][ni][j];
        if (!isv) {
          float ss = val[0] * val[0] + val[1] * val[1] + val[2] * val[2] + val[3] * val[3];
          ss += __shfl_xor(ss, 1); ss += __shfl_xor(ss, 2); ss += __shfl_xor(ss, 4); ss += __shfl_xor(ss, 8);
          const float rstd = rsqrtf(ss * (1.f / 64.f) + EPS);
#pragma unroll
          for (int ni = 0; ni < 4; ni++) val[ni] = val[ni] * rstd * qw[ni];
        }
        if (!latent) {
          const int b = row >> 8, t = row & 255;
          if (isq) {
            bf16_t* q = (typeC ? P->qC : P->qB) + (size_t)row * 512 + hh * 64;
#pragma unroll
            for (int ni = 0; ni < 4; ni++) q[ni * 16 + lr] = f2bf(val[ni] * QSCALE);
          } else if (isk) {
            bf16_t* kc = (typeC ? P->kcC : P->kcB) + ((size_t)(b * 2 + kvh) * 256 + t) * 64;
            float* ko = P->out + (typeC ? OUT_KW : OUT_KG) + (((size_t)(b * 4 + l) * 256 + t) * 2 + kvh) * 64;
#pragma unroll
            for (int ni = 0; ni < 4; ni++) { kc[ni * 16 + lr] = f2bf(val[ni]); ko[ni * 16 + lr] = val[ni]; }
          } else {
            bf16_t* vt = (typeC ? P->vtcC : P->vtcB) + (size_t)(b * 2 + kvh) * 64 * 256 + t;
            float* vo = P->out + (typeC ? OUT_VW : OUT_VG) + (((size_t)(b * 4 + l) * 256 + t) * 2 + kvh) * 64;
#pragma unroll
            for (int ni = 0; ni < 4; ni++) { vt[(size_t)(ni * 16 + lr) * 256] = f2bf(val[ni]); vo[ni * 16 + lr] = val[ni]; }
          }
        } else {
          const int b = (row - NCTX) >> 12, t = (row - NCTX) & 4095;
          if (!isv) {
            const float c0 = P->ropec[t * 32 + lr], c1 = P->ropec[t * 32 + 16 + lr];
            const float s0 = P->ropes[t * 32 + lr], s1 = P->ropes[t * 32 + 16 + lr];
            const float x10 = val[0], x11 = val[1], x20 = val[2], x21 = val[3];
            val[0] = x10 * c0 - x20 * s0; val[2] = x20 * c0 + x10 * s0;
            val[1] = x11 * c1 - x21 * s1; val[3] = x21 * c1 + x11 * s1;
          }
          if (isq) {
            bf16_t* q = (typeC ? P->qC : P->qB) + (size_t)row * 512 + hh * 64;
#pragma unroll
            for (int ni = 0; ni < 4; ni++) q[ni * 16 + lr] = f2bf(val[ni] * QSCALE);
          } else if (isk) {
            bf16_t* kf = (typeC ? P->kfC : P->kfB) + ((size_t)(b * 2 + kvh) * LFULL + 512 + t) * 64;
#pragma unroll
            for (int ni = 0; ni < 4; ni++) kf[ni * 16 + lr] = f2bf(val[ni]);
          } else {
            bf16_t* vt = (typeC ? P->vtfC : P->vtfB) + (size_t)(b * 2 + kvh) * 64 * LFULL + 512 + t;
#pragma unroll
            for (int ni = 0; ni < 4; ni++) vt[(size_t)(ni * 16 + lr) * LFULL] = f2bf(val[ni]);
          }
        }
      }
  } else if (w64 < 105) {
#pragma unroll
    for (int mi = 0; mi < 8; mi++)
#pragma unroll
      for (int j = 0; j < 4; j++) {
        const size_t row = row0 + mi * 16 + quad * 4 + j;
#pragma unroll
        for (int ni = 0; ni < 4; ni++) P->gates[row * 3072 + (w64 - 57) * 64 + ni * 16 + lr] = f2bf(sigmoidf_(acc[mi][ni][j]));
      }
  }
}

constexpr int GEMM_D_N = 96 * 8;
constexpr int GEMM_BR_N = 96 * 16;

DI void gemm_br_item(CP P, int l, int item, char* smem) {
  const int mt = item % 96, nt = item / 96;
  const int m0 = mt * 128, n0 = nt * 64;
  const int tid = tidx(), lane = tid & 63, wid = tid >> 6, wm = wid >> 1, wn = wid & 1, lr = lane & 15, quad = lane >> 4;
  const int row0 = m0 + wm * 64, col0 = n0 + wn * 32;
  f32x4 tot[4][2];
  zero_acc<2>(tot);
#pragma unroll 1
  for (int br = 0; br < 3; br++) {
    f32x4 acc[4][2];
    zero_acc<2>(acc);
    const bf16_t* A = br == 0 ? P->ya : br == 1 ? P->yb : P->yc;
    gemm_mainloop<2>(A, 512, P->wt_br + (size_t)(l * 3 + br) * 1024 * 512, 512, 512, m0, n0, (bf16_t*)smem, acc);
#pragma unroll
    for (int mi = 0; mi < 4; mi++)
#pragma unroll
      for (int j = 0; j < 4; j++) {
        const size_t row = row0 + mi * 16 + quad * 4 + j;
#pragma unroll
        for (int ni = 0; ni < 2; ni++) tot[mi][ni][j] += bf2f(P->gates[row * 3072 + br * 1024 + col0 + ni * 16 + lr]) * acc[mi][ni][j];
      }
  }
#pragma unroll
  for (int mi = 0; mi < 4; mi++)
#pragma unroll
    for (int j = 0; j < 4; j++) {
      const size_t row = row0 + mi * 16 + quad * 4 + j;
#pragma unroll
      for (int ni = 0; ni < 2; ni++) P->h[row * DM + col0 + ni * 16 + lr] = f2bf(tot[mi][ni][j]);
    }
}

constexpr int GEMM_RES_N = 1024;
template <int NI>
DI void gemm_res_tile(CP P, int l, char* smem, const bf16_t* A, int K, const bf16_t* Bt, int gate_off, int m0, int n0) {
  f32x4 acc[4][NI];
  zero_acc<NI>(acc);
  gemm_mainloop<NI>(A, K, Bt, K, K, m0, n0, (bf16_t*)smem, acc);
  const int tid = tidx(), lane = tid & 63, wid = tid >> 6, wm = wid >> 1, wn = wid & 1, lr = lane & 15, quad = lane >> 4;
  const int row0 = m0 + wm * 64, col0 = n0 + wn * 16 * NI;
  const float* g = P->mods + ((size_t)l * 3 + mod_index(row0)) * 6144 + gate_off + col0;
  float gv[NI];
#pragma unroll
  for (int ni = 0; ni < NI; ni++) gv[ni] = g[ni * 16 + lr];
#pragma unroll
  for (int mi = 0; mi < 4; mi++)
#pragma unroll
    for (int j = 0; j < 4; j++) {
      const size_t row = row0 + mi * 16 + quad * 4 + j;
#pragma unroll
      for (int ni = 0; ni < NI; ni++) {
        float* xp = P->out + row * DM + col0 + ni * 16 + lr;
        *xp = *xp + gv[ni] * acc[mi][ni][j];
      }
    }
}
DI void gemm_res_item(CP P, int l, int item, char* smem, const bf16_t* A, int K, const bf16_t* Bt, int gate_off) {
  if (item < 512) {
    gemm_res_tile<4>(P, l, smem, A, K, Bt, gate_off, (item % 96) * 128, (item / 96) * 128);
  } else {
    const int hi = item - 512, tile = 512 + (hi >> 1);
    gemm_res_tile<2>(P, l, smem, A, K, Bt, gate_off, (tile % 96) * 128, (tile / 96) * 128 + (hi & 1) * 64);
  }
}

constexpr int GEMM_FF2R_N = 64 * 8;
DI void gemm_res_ring_item(CP P, int l, int item, char* smem, const bf16_t* A, int K, const bf16_t* Bt, int gate_off) {
  const int mt = item % 64, nt = item / 64;
  const int m0 = mt * 192, n0 = nt * 128;
  f32x4 acc[6][4];
  zero_acc2<6, 4>(acc);
  gemm_mainloop3<6, 4>(A, K, Bt, K, K, m0, n0, smem, acc);
  const int tid = tidx(), lane = tid & 63, wid = tid >> 6, wm = wid >> 1, wn = wid & 1, lr = lane & 15, quad = lane >> 4;
  const int row0 = m0 + wm * 96, col0 = n0 + wn * 64;
#pragma unroll
  for (int mi = 0; mi < 6; mi++) {
    const float* g = P->mods + ((size_t)l * 3 + mod_index(row0 + mi * 16)) * 6144 + gate_off + col0;
    float gv[4];
#pragma unroll
    for (int ni = 0; ni < 4; ni++) gv[ni] = g[ni * 16 + lr];
#pragma unroll
    for (int j = 0; j < 4; j++) {
      const size_t row = row0 + mi * 16 + quad * 4 + j;
#pragma unroll
      for (int ni = 0; ni < 4; ni++) {
        float* xp = P->out + row * DM + col0 + ni * 16 + lr;
        *xp = *xp + gv[ni] * acc[mi][ni][j];
      }
    }
  }
}

constexpr int GEMM_FF1_N = 48 * 32;
DI void gemm_ff1_item(CP P, int l, int item, char* smem) {
  int mt, nt;
  tile_map(item, 48, 32, mt, nt);
  const int m0 = mt * 256, n0 = nt * 128;
  f32x4 acc[8][4];
  zero_acc2<8, 4>(acc);
  gemm_mainloop3<8, 4>(P->h, DM, P->wt_ff1 + (size_t)l * DFF * 1024, 1024, 1024, m0, n0, smem, acc);
  const int tid = tidx(), lane = tid & 63, wid = tid >> 6, wm = wid >> 1, wn = wid & 1, lr = lane & 15, quad = lane >> 4;
  const int row0 = m0 + wm * 128, col0 = n0 + wn * 64;
#pragma unroll
  for (int mi = 0; mi < 8; mi++)
#pragma unroll
    for (int j = 0; j < 4; j++) {
      const size_t row = row0 + mi * 16 + quad * 4 + j;
#pragma unroll
      for (int ni = 0; ni < 4; ni++) {
        const float r = fmaxf(acc[mi][ni][j], 0.f);
        P->f[row * DFF + col0 + ni * 16 + lr] = f2bf(r * r);
      }
    }
}

#define MFMA16K16(a, b, c) __builtin_amdgcn_mfma_f32_16x16x16bf16_1k((a), (b), (c), 0, 0, 0)
DI unsigned bf16_sw(float f) { unsigned u = __float_as_uint(f); u += 0x7fffu + ((u >> 16) & 1u); return u >> 16; }
DI bf16x4 pack4(float x0, float x1, float x2, float x3) {
  typedef __attribute__((ext_vector_type(2))) unsigned u32x2_t;
  u32x2_t t;
  t[0] = bf16_sw(x0) | (bf16_sw(x1) << 16);
  t[1] = bf16_sw(x2) | (bf16_sw(x3) << 16);
  return __builtin_bit_cast(bf16x4, t);
}

DI void gdn_dinv(const float* M, float* Dv, int tid) {
  const int dir = tid >> 6, blk = (tid >> 4) & 3, c = tid & 15;
  const float* Mb = M + (blk * 16) * 64 + blk * 16;
  float y[16];
  if (dir == 0) {
#pragma unroll
    for (int r = 0; r < 16; r++) {
      float a = (r == c) ? 1.f : 0.f;
#pragma unroll
      for (int j = 0; j < 16; j++) if (j < r) a -= Mb[r * 64 + j] * y[j];
      y[r] = a;
    }
  } else {
#pragma unroll
    for (int rr = 0; rr < 16; rr++) {
      const int r = 15 - rr;
      float a = (r == c) ? 1.f : 0.f;
#pragma unroll
      for (int j = 0; j < 16; j++) if (j > r) a -= Mb[r * 64 + j] * y[j];
      y[r] = a;
    }
  }
  float* d = Dv + (dir * 4 + blk) * 256 + c;
#pragma unroll
  for (int r = 0; r < 16; r++) d[r * 16] = y[r];
}

DI void gdn_solve_blocked(CP P, const float* M, const float* Dv, const float* vec, const bf16_t* kb, const bf16_t* vb, int tid, int n0, int h) {
  const int lane = tid & 63, wid = tid >> 6, lr = lane & 15, quad = lane >> 4;
  const int dir = wid >> 1, ch = wid & 1;
  const float* bvec = vec + dir * 64;
  const float* egv = vec + 256 + dir * 64;
  const bf16_t* src = ch ? kb : vb;
  bf16_t* dst = (ch ? P->gw : P->gu) + (size_t)dir * NTOK * 512 + (size_t)n0 * 512 + h * 64;
  bf16x4 XB[4][4];
#pragma unroll
  for (int s = 0; s < 4; s++) {
    const int i = dir ? 3 - s : s;
    f32x4 T[4];
#pragma unroll
    for (int j = 0; j < 4; j++) {
      const int p = i * 16 + quad * 4 + j;
      const float sc = bvec[p] * (ch ? egv[p] : 1.f);
#pragma unroll
      for (int nt = 0; nt < 4; nt++) T[nt][j] = sc * bf2f(src[p * 72 + nt * 16 + lr]);
    }
#pragma unroll
    for (int q = 0; q < 4; q++) {
      if (q < s) {
        const int jb = dir ? 3 - q : q;
        const float4 m4 = *(const float4*)(M + (i * 16 + lr) * 64 + jb * 16 + quad * 4);
        const bf16x4 am = pack4(-m4.x, -m4.y, -m4.z, -m4.w);
#pragma unroll
        for (int nt = 0; nt < 4; nt++) T[nt] = MFMA16K16(am, XB[q][nt], T[nt]);
      }
    }
    const float4 d4 = *(const float4*)(Dv + ((dir * 4 + i) * 16 + lr) * 16 + quad * 4);
    const bf16x4 ad = pack4(d4.x, d4.y, d4.z, d4.w);
#pragma unroll
    for (int nt = 0; nt < 4; nt++) {
      const bf16x4 tb = pack4(T[nt][0], T[nt][1], T[nt][2], T[nt][3]);
      const f32x4 X = MFMA16K16(ad, tb, ((f32x4){0.f, 0.f, 0.f, 0.f}));
      XB[s][nt] = pack4(X[0], X[1], X[2], X[3]);
#pragma unroll
      for (int j = 0; j < 4; j++) dst[(size_t)(i * 16 + quad * 4 + j) * 512 + nt * 16 + lr] = (bf16_t)bf16_sw(X[j]);
    }
  }
}

constexpr int GDNA_N = 192 * 8;

DI void gdn_a_item(CP P, int l, int item, char* smem) {
  const int tid = tidx(), lane = tid & 63, wid = tid >> 6, lr = lane & 15, quad = lane >> 4;
  const int gcx = item >> 3, h = item & 7;
  const int n0 = gcx * 64;
  int s0, s1;
  if (n0 < NCTX) { s0 = n0 & ~255; s1 = s0 + 256; } else { s0 = NCTX + ((n0 - NCTX) & ~4095); s1 = s0 + 4096; }
  bf16_t* kb = (bf16_t*)smem;
  bf16_t* vb = kb + 4608;
  float* M = (float*)(smem + 18432);
  float* vec = M + 4096;
  bf16_t* qb = (bf16_t*)(smem + 36352);
  float* cwl = (float*)(smem + 36352 + 9216);
  float* Dv = (float*)(smem + 36352);
  __syncthreads();
  for (int i = tid; i < 960; i += 256) {
    const int j = i / 192, cc = i % 192, sect = cc >> 6;
    cwl[i] = P->conv[((size_t)l * 5 + j) * 1536 + sect * 512 + h * 64 + (cc & 63)];
  }
  if (wid < 2) {
    const int dir = wid, pp = lane;
    const size_t n = (size_t)n0 + pp;
    const float braw = P->ba[n * 32 + dir * 8 + h];
    const float araw = P->ba[n * 32 + 16 + dir * 8 + h] + P->dt_bias[l * 16 + dir * 8 + h];
    const float sp = araw > 20.f ? araw : log1pf(expf(araw));
    float x = -expf(P->a_log[l * 16 + dir * 8 + h]) * sp;
#pragma unroll
    for (int o = 1; o < 64; o <<= 1) {
      const float yu = __shfl_up(x, o), yd = __shfl_down(x, o);
      if (dir ? (lane + o < 64) : (lane >= o)) x += dir ? yd : yu;
    }
    vec[dir * 64 + pp] = sigmoidf_(braw);
    vec[128 + dir * 64 + pp] = x;
    vec[256 + dir * 64 + pp] = __expf(x);
  }
  __syncthreads();
  {
    const int r = tid >> 2, part = tid & 3;
    const int n = n0 + r;
    float acc[3][16];
#pragma unroll
    for (int sct = 0; sct < 3; sct++)
#pragma unroll
      for (int i = 0; i < 16; i++) acc[sct][i] = 0.f;
#pragma unroll
    for (int j = 0; j < 5; j++) {
      const int nn = n + j - 2;
      if (nn >= s0 && nn < s1) {
#pragma unroll
        for (int sct = 0; sct < 3; sct++) {
          union { uint4 u[2]; bf16_t b[16]; } x;
          const bf16_t* src = P->qkv_raw + (size_t)nn * 1536 + sct * 512 + h * 64 + part * 16;
          x.u[0] = *(const uint4*)src; x.u[1] = *(const uint4*)(src + 8);
          const float* cw = cwl + j * 192 + sct * 64 + part * 16;
#pragma unroll
          for (int i = 0; i < 16; i++) acc[sct][i] += cw[i] * bf2f(x.b[i]);
        }
      }
    }
#pragma unroll
    for (int sct = 0; sct < 3; sct++) {
      float ss = 0.f;
#pragma unroll
      for (int i = 0; i < 16; i++) { acc[sct][i] = siluf_(acc[sct][i]); ss += acc[sct][i] * acc[sct][i]; }
      if (sct < 2) {
        ss += __shfl_xor(ss, 1); ss += __shfl_xor(ss, 2);
        const float sc = rsqrtf(ss + EPS) * (sct == 0 ? 0.125f : 1.f);
#pragma unroll
        for (int i = 0; i < 16; i++) acc[sct][i] *= sc;
      }
      union { uint4 u[2]; unsigned w[8]; } o;
#pragma unroll
      for (int i = 0; i < 8; i++) o.w[i] = pack2(acc[sct][2 * i], acc[sct][2 * i + 1]);
      bf16_t* dl = (sct == 0 ? qb : sct == 1 ? kb : vb) + r * 72 + part * 16;
      *(uint4*)dl = o.u[0]; *(uint4*)(dl + 8) = o.u[1];
      if (sct == 0) { bf16_t* dg = P->gq + (size_t)n * 512 + h * 64 + part * 16; *(uint4*)dg = o.u[0]; *(uint4*)(dg + 8) = o.u[1]; }
    }
  }
  __syncthreads();
  {
    bf16x8 ak[2], aq[2];
#pragma unroll
    for (int ks = 0; ks < 2; ks++) {
      ak[ks] = *(const bf16x8*)(kb + (wid * 16 + lr) * 72 + ks * 32 + quad * 8);
      aq[ks] = *(const bf16x8*)(qb + (wid * 16 + lr) * 72 + ks * 32 + quad * 8);
    }
    const float* b0 = vec; const float* b1 = vec + 64; const float* G0 = vec + 128; const float* G1 = vec + 192;
#pragma unroll
    for (int ni = 0; ni < 4; ni++) {
      f32x4 ckk = (f32x4){0.f, 0.f, 0.f, 0.f}, cqk = (f32x4){0.f, 0.f, 0.f, 0.f};
#pragma unroll
      for (int ks = 0; ks < 2; ks++) {
        const bf16x8 bk = *(const bf16x8*)(kb + (ni * 16 + lr) * 72 + ks * 32 + quad * 8);
        ckk = MFMA16(ak[ks], bk, ckk);
        cqk = MFMA16(aq[ks], bk, cqk);
      }
      const int pp = ni * 16 + lr;
#pragma unroll
      for (int j = 0; j < 4; j++) {
        const int p = wid * 16 + quad * 4 + j;
        float m = 0.f, at0 = 0.f, at1 = 0.f;
        if (pp < p) { const float dec = __expf(G0[p] - G0[pp]); m = b0[p] * ckk[j] * dec; at0 = cqk[j] * dec; }
        else if (pp > p) { const float dec = __expf(G1[p] - G1[pp]); m = b1[p] * ckk[j] * dec; at1 = cqk[j] * dec; }
        else { at0 = cqk[j]; at1 = cqk[j]; }
        M[p * 64 + pp] = m;
        const size_t gi = ((size_t)n0 + p) * 512 + h * 64 + pp;
        P->gattn[gi] = f2bf(at0);
        P->gattn[(size_t)NTOK * 512 + gi] = f2bf(at1);
      }
    }
  }
  {
    const int d = tid >> 2, pg = tid & 3;
    union { uint4 u[2]; bf16_t b[16]; } o;
#pragma unroll
    for (int i = 0; i < 16; i++) o.b[i] = kb[(pg * 16 + i) * 72 + d];
    bf16_t* dg = P->gkT + ((size_t)item * 64 + d) * 64 + pg * 16;
    *(uint4*)dg = o.u[0]; *(uint4*)(dg + 8) = o.u[1];
  }
  if (tid < 128) {
    const int dir = tid >> 6, pp = tid & 63;
    const float glast = dir ? vec[192] : vec[128 + 63];
    const size_t vi = (size_t)dir * NTOK * 8 + ((size_t)n0 + pp) * 8 + h;
    P->geg[vi] = vec[256 + dir * 64 + pp];
    P->gks[vi] = __expf(glast - vec[128 + dir * 64 + pp]);
    if (pp == 0) P->ggl[dir * 1536 + item] = __expf(glast);
  }
  __syncthreads();
  if (tid < 128) gdn_dinv(M, Dv, tid);
  __syncthreads();
  gdn_solve_blocked(P, M, Dv, vec, kb, vb, tid, n0, h);
}

DI void attn_item(const bf16_t* __restrict__ Q, const bf16_t* __restrict__ Kp, const bf16_t* __restrict__ Vt, int vstride, int nA, int tb0, int tb1,
                  int qpos0, bool has_sink, float sinkv, bf16_t* __restrict__ Y, bf16_t* smb) {
  char* sm = (char*)smb;
  const int tid = tidx(), lane = tid & 63, wid = tid >> 6, lr = lane & 15, quad = lane >> 4;
  bf16x8 bq[2][2];
#pragma unroll
  for (int qt = 0; qt < 2; qt++)
#pragma unroll
    for (int ks = 0; ks < 2; ks++) bq[qt][ks] = *(const bf16x8*)(Q + (size_t)(wid * 32 + qt * 16 + lr) * 512 + ks * 32 + quad * 8);
  int offK[4][2], offV[4][2][2];
#pragma unroll
  for (int t = 0; t < 4; t++)
#pragma unroll
    for (int ks = 0; ks < 2; ks++) {
      offK[t][ks] = lds_byte(t * 16 + lr, ks * 32 + quad * 8);
      offV[t][ks][0] = 8192 + lds_byte(t * 16 + lr, ks * 32 + quad * 4);
      offV[t][ks][1] = 8192 + lds_byte(t * 16 + lr, ks * 32 + 16 + quad * 4);
    }
  f32x4 O[4][2];
#pragma unroll
  for (int dt = 0; dt < 4; dt++) { O[dt][0] = (f32x4){0.f, 0.f, 0.f, 0.f}; O[dt][1] = (f32x4){0.f, 0.f, 0.f, 0.f}; }
  float mrun[2];
  f32x4 lsum4[2];
  sinkv *= LOG2E;
  mrun[0] = mrun[1] = has_sink ? sinkv : -1e30f;
  lsum4[0] = lsum4[1] = (f32x4){0.f, 0.f, 0.f, 0.f};
  const int npairs = (nA + (tb1 - tb0)) >> 1, nAp = nA >> 1;
  __syncthreads();
  {
    const int t0 = (nAp > 0 ? 0 : tb0);
    stage_tile<64>(Kp + (size_t)t0 * 4096, 64, sm, tid);
    stage_tile<64>(Vt + t0 * 64, vstride, sm + 8192, tid);
    stage_tile<64>(Kp + (size_t)(t0 + 1) * 4096, 64, sm + 16384, tid);
    stage_tile<64>(Vt + (t0 + 1) * 64, vstride, sm + 24576, tid);
  }
  asm volatile("s_waitcnt vmcnt(0)" ::: "memory");
  __syncthreads();
  for (int ip = 0; ip < npairs; ip++) {
    const bool masked = ip >= nAp;
    const int tile0 = masked ? tb0 + 2 * (ip - nAp) : 2 * ip;
    const int cur = ip & 1;
    if (ip + 1 < npairs) {
      const int tn = (ip + 1 >= nAp) ? tb0 + 2 * (ip + 1 - nAp) : 2 * (ip + 1);
      char* nb = sm + (cur ^ 1) * 32768;
      stage_tile<64>(Kp + (size_t)tn * 4096, 64, nb, tid);
      stage_tile<64>(Vt + tn * 64, vstride, nb + 8192, tid);
      stage_tile<64>(Kp + (size_t)(tn + 1) * 4096, 64, nb + 16384, tid);
      stage_tile<64>(Vt + (tn + 1) * 64, vstride, nb + 24576, tid);
    }
#pragma unroll 1
    for (int sub = 0; sub < 2; sub++) {
    const int p0 = (tile0 + sub) * 64;
    const char* cb = sm + cur * 32768 + sub * 16384;
    f32x4 s[4][2];
    __builtin_amdgcn_s_setprio(1);
#pragma unroll
    for (int kt = 0; kt < 4; kt++) {
      const bf16x8 a0 = *(const bf16x8*)(cb + offK[kt][0]);
      const bf16x8 a1 = *(const bf16x8*)(cb + offK[kt][1]);
#pragma unroll
      for (int qt = 0; qt < 2; qt++) {
        f32x4 t = MFMA16(a0, bq[qt][0], ((f32x4){0.f, 0.f, 0.f, 0.f}));
        s[kt][qt] = MFMA16(a1, bq[qt][1], t);
      }
    }
    __builtin_amdgcn_s_setprio(0);
    if (masked) {
#pragma unroll
      for (int kt = 0; kt < 4; kt++)
#pragma unroll
        for (int qt = 0; qt < 2; qt++)
#pragma unroll
          for (int j = 0; j < 4; j++) {
            const int key = p0 + kt * 16 + quad * 4 + j;
            const int qp = qpos0 + wid * 32 + qt * 16 + lr;
            const int d = key - qp;
            if (d > 128 || d < -128) s[kt][qt][j] = -1e30f;
          }
    }
    float mx[2];
#pragma unroll
    for (int qt = 0; qt < 2; qt++) {
      const f32x4 m01 = __builtin_elementwise_max(s[0][qt], s[1][qt]);
      const f32x4 m23 = __builtin_elementwise_max(s[2][qt], s[3][qt]);
      const f32x4 m4 = __builtin_elementwise_max(m01, m23);
      float m = fmaxf(fmaxf(m4[0], m4[1]), fmaxf(m4[2], m4[3]));
      m = fmaxf(m, __shfl_xor(m, 16));
      m = fmaxf(m, __shfl_xor(m, 32));
      mx[qt] = m;
    }
    if (__any((mx[0] > mrun[0] + 8.f) || (mx[1] > mrun[1] + 8.f))) {
#pragma unroll
      for (int qt = 0; qt < 2; qt++) {
        const float mnew = fmaxf(mrun[qt], mx[qt]);
        const float alpha = __builtin_amdgcn_exp2f(mrun[qt] - mnew);
        mrun[qt] = mnew;
        lsum4[qt] *= alpha;
#pragma unroll
        for (int dt = 0; dt < 4; dt++) O[dt][qt] *= alpha;
      }
    }
#pragma unroll
    for (int qt = 0; qt < 2; qt++) {
      const float mr = mrun[qt];
#pragma unroll
      for (int kt = 0; kt < 4; kt++) {
        const f32x4 d = s[kt][qt] - mr;
        f32x4 pv;
        pv[0] = __builtin_amdgcn_exp2f(d[0]); pv[1] = __builtin_amdgcn_exp2f(d[1]); pv[2] = __builtin_amdgcn_exp2f(d[2]); pv[3] = __builtin_amdgcn_exp2f(d[3]);
        s[kt][qt] = pv;
        lsum4[qt] += pv;
      }
    }
    __builtin_amdgcn_s_setprio(1);
#pragma unroll
    for (int kk = 0; kk < 2; kk++) {
      bf16x8 bp[2];
#pragma unroll
      for (int qt = 0; qt < 2; qt++) {
        bp[qt] = pack8(s[2 * kk][qt][0], s[2 * kk][qt][1], s[2 * kk][qt][2], s[2 * kk][qt][3],
                       s[2 * kk + 1][qt][0], s[2 * kk + 1][qt][1], s[2 * kk + 1][qt][2], s[2 * kk + 1][qt][3]);
      }
#pragma unroll
      for (int dt = 0; dt < 4; dt++) {
        const bf16x4 v0 = *(const bf16x4*)(cb + offV[dt][kk][0]);
        const bf16x4 v1 = *(const bf16x4*)(cb + offV[dt][kk][1]);
        const bf16x8 av = __builtin_shufflevector(v0, v1, 0, 1, 2, 3, 4, 5, 6, 7);
#pragma unroll
        for (int qt = 0; qt < 2; qt++) O[dt][qt] = MFMA16(av, bp[qt], O[dt][qt]);
      }
    }
    __builtin_amdgcn_s_setprio(0);
    }
    asm volatile("s_waitcnt vmcnt(0)" ::: "memory");
    __syncthreads();
  }
#pragma unroll
  for (int qt = 0; qt < 2; qt++) {
    float lt = (lsum4[qt][0] + lsum4[qt][1]) + (lsum4[qt][2] + lsum4[qt][3]);
    lt += __shfl_xor(lt, 16);
    lt += __shfl_xor(lt, 32);
    if (has_sink) lt += __builtin_amdgcn_exp2f(sinkv - mrun[qt]);
    const float inv = 1.f / lt;
    bf16_t* yr = Y + (size_t)(wid * 32 + qt * 16 + lr) * 512;
#pragma unroll
    for (int dt = 0; dt < 4; dt++) {
      uint2 o;
      o.x = pack2(O[dt][qt][0] * inv, O[dt][qt][1] * inv);
      o.y = pack2(O[dt][qt][2] * inv, O[dt][qt][3] * inv);
      *(uint2*)(yr + dt * 16 + quad * 4) = o;
    }
  }
}

DI bf16x8 frag_perm(const bf16_t* base, int row, int kk, int quad) {
  const bf16_t* p = base + row * 72 + kk * 32 + quad * 4;
  const bf16x4 v0 = *(const bf16x4*)p;
  const bf16x4 v1 = *(const bf16x4*)(p + 16);
  return __builtin_shufflevector(v0, v1, 0, 1, 2, 3, 4, 5, 6, 7);
}
DI bf16x8 pack_c2(const f32x4& a, const f32x4& b) { return pack8(a[0], a[1], a[2], a[3], b[0], b[1], b[2], b[3]); }

DI void gdn_scan_item(CP P, int l, int seq, int h, int dir, char* smem) {
  const int tid = tidx(), lane = tid & 63, wid = tid >> 6, lr = lane & 15, quad = lane >> 4;
  const bool ctx = seq < 16;
  const int nch = ctx ? 4 : 64;
  const int n0 = ctx ? seq * 256 : NCTX + (seq - 16) * 4096;
  const int ch0 = n0 >> 6;
  bf16_t* sQ = (bf16_t*)smem;
  bf16_t* sKT = sQ + 4608;
  bf16_t* sW = sKT + 4608;
  bf16_t* sA = sW + 4608;
  bf16_t* sU = sA + 4608;
  float* sEg = (float*)(smem + 46080);
  float* sKs = sEg + 64;
  float* sGl = sKs + 64;
  f32x4 S[4];
  if (ctx) {
#pragma unroll
    for (int mi = 0; mi < 4; mi++) S[mi] = (f32x4){0.f, 0.f, 0.f, 0.f};
  } else {
    const float* src = P->state + ((((size_t)(seq - 16) * 4 + l) * 2 + dir) * 8 + h) * 4096;
#pragma unroll
    for (int mi = 0; mi < 4; mi++)
#pragma unroll
      for (int j = 0; j < 4; j++) S[mi][j] = src[(mi * 16 + quad * 4 + j) * 64 + wid * 16 + lr];
  }
  const size_t doff = (size_t)dir * NTOK * 512;
  uint4 pq0, pq1, pk0, pk1, pw0, pw1, pa0, pa1, pu0, pu1;
  float pv = 0.f;
  const int lrow = tid >> 3, lcol = (tid & 7) * 8;
#define GDN_ISSUE1(i_, Q_, K_, W_, A_, U_) { \
      const size_t ro = tb + (size_t)(lrow + 32 * (i_)) * 512 + lcol; \
      Q_ = *(const uint4*)(P->gq + ro); \
      K_ = *(const uint4*)(P->gkT + ((size_t)((ch0 + c__) * 8 + h) * 64 + lrow + 32 * (i_)) * 64 + lcol); \
      W_ = *(const uint4*)(P->gw + doff + ro); \
      A_ = *(const uint4*)(P->gattn + doff + ro); \
      U_ = *(const uint4*)(P->gu + doff + ro); }
#define GDN_ISSUE(c_) do { const int c__ = (c_); \
    const size_t tb = ((size_t)n0 + c__ * 64) * 512 + h * 64; \
    GDN_ISSUE1(0, pq0, pk0, pw0, pa0, pu0) \
    GDN_ISSUE1(1, pq1, pk1, pw1, pa1, pu1) \
    if (tid < 64) pv = P->geg[(size_t)dir * NTOK * 8 + ((size_t)n0 + c__ * 64 + tid) * 8 + h]; \
    else if (tid < 128) pv = P->gks[(size_t)dir * NTOK * 8 + ((size_t)n0 + c__ * 64 + tid - 64) * 8 + h]; \
    else if (tid == 128) pv = P->ggl[dir * 1536 + (ch0 + c__) * 8 + h]; \
  } while (0)
  GDN_ISSUE(dir ? nch - 1 : 0);
  for (int cc = 0; cc < nch; cc++) {
    const int c = dir ? nch - 1 - cc : cc;
    __syncthreads();
    {
      const int so0 = lrow * 72 + lcol, so1 = (lrow + 32) * 72 + lcol;
      *(uint4*)(sQ + so0) = pq0; *(uint4*)(sQ + so1) = pq1;
      *(uint4*)(sKT + so0) = pk0; *(uint4*)(sKT + so1) = pk1;
      *(uint4*)(sW + so0) = pw0; *(uint4*)(sW + so1) = pw1;
      *(uint4*)(sA + so0) = pa0; *(uint4*)(sA + so1) = pa1;
      *(uint4*)(sU + so0) = pu0; *(uint4*)(sU + so1) = pu1;
    }
    if (tid < 64) sEg[tid] = pv; else if (tid < 128) sKs[tid - 64] = pv; else if (tid == 128) sGl[0] = pv;
    __syncthreads();
    if (cc + 1 < nch) GDN_ISSUE(dir ? nch - 2 - cc : cc + 1);
    bf16x8 sB[2];
    sB[0] = pack_c2(S[0], S[1]);
    sB[1] = pack_c2(S[2], S[3]);
    f32x4 U[4], QS[4];
#pragma unroll
    for (int mi = 0; mi < 4; mi++) {
      f32x4 aw = (f32x4){0.f, 0.f, 0.f, 0.f}, aq = (f32x4){0.f, 0.f, 0.f, 0.f};
#pragma unroll
      for (int kk = 0; kk < 2; kk++) {
        aw = MFMA16(frag_perm(sW, mi * 16 + lr, kk, quad), sB[kk], aw);
        aq = MFMA16(frag_perm(sQ, mi * 16 + lr, kk, quad), sB[kk], aq);
      }
#pragma unroll
      for (int j = 0; j < 4; j++) U[mi][j] = bf2f(sU[(mi * 16 + quad * 4 + j) * 72 + wid * 16 + lr]) - aw[j];
      QS[mi] = aq;
    }
    bf16x8 uB[2], usB[2];
    {
      f32x4 t[4];
#pragma unroll
      for (int mi = 0; mi < 4; mi++)
#pragma unroll
        for (int j = 0; j < 4; j++) t[mi][j] = U[mi][j] * sKs[mi * 16 + quad * 4 + j];
      uB[0] = pack_c2(U[0], U[1]); uB[1] = pack_c2(U[2], U[3]);
      usB[0] = pack_c2(t[0], t[1]); usB[1] = pack_c2(t[2], t[3]);
    }
    bf16_t* og = P->obf + doff + ((size_t)n0 + c * 64) * 512 + h * 64 + wid * 16 + lr;
#pragma unroll
    for (int mi = 0; mi < 4; mi++) {
      f32x4 aa = (f32x4){0.f, 0.f, 0.f, 0.f};
#pragma unroll
      for (int kk = 0; kk < 2; kk++) aa = MFMA16(frag_perm(sA, mi * 16 + lr, kk, quad), uB[kk], aa);
#pragma unroll
      for (int j = 0; j < 4; j++) {
        const int pr = mi * 16 + quad * 4 + j;
        og[(size_t)pr * 512] = f2bf(sEg[pr] * QS[mi][j] + aa[j]);
      }
    }
    const float gl = sGl[0];
#pragma unroll
    for (int mi = 0; mi < 4; mi++) {
      f32x4 ak = (f32x4){0.f, 0.f, 0.f, 0.f};
#pragma unroll
      for (int kk = 0; kk < 2; kk++) ak = MFMA16(frag_perm(sKT, mi * 16 + lr, kk, quad), usB[kk], ak);
#pragma unroll
      for (int j = 0; j < 4; j++) S[mi][j] = gl * S[mi][j] + ak[j];
    }
  }
  if (ctx) {
    float* dst = P->out + OUT_ST + ((((size_t)seq * 4 + l) * 2 + dir) * 8 + h) * 4096;
#pragma unroll
    for (int mi = 0; mi < 4; mi++)
#pragma unroll
      for (int j = 0; j < 4; j++) dst[(mi * 16 + quad * 4 + j) * 64 + wid * 16 + lr] = S[mi][j];
  }
}

constexpr int MIX_GL = 32, MIX_BL = 512, MIX_CL = 512, MIX_GC = 256, MIX_BC = 256, MIX_CC = 256;
constexpr int MIX_N = MIX_GL + MIX_BL + MIX_CL + MIX_GC + MIX_BC + MIX_CC;

DI void mix_item(CP P, int l, int item, char* smem) {
  if (item < MIX_GL) { gdn_scan_item(P, l, 16 + (item >> 4), (item >> 1) & 7, item & 1, smem); return; }
  item -= MIX_GL;
  if (item < MIX_BL + MIX_CL) {
    const int typeC = item >= MIX_BL;
    const int i = typeC ? item - MIX_BL : item;
    const int b = i >> 8, head = (i >> 5) & 7, qb = i & 31, kvh = head >> 2;
    const size_t tok0 = (size_t)NCTX + b * 4096 + qb * 128;
    const bf16_t* Q = (typeC ? P->qC : P->qB) + tok0 * 512 + head * 64;
    const bf16_t* Kp = (typeC ? P->kfC : P->kfB) + (size_t)(b * 2 + kvh) * LFULL * 64;
    const bf16_t* Vt = (typeC ? P->vtfC : P->vtfB) + (size_t)(b * 2 + kvh) * 64 * LFULL;
    bf16_t* Y = (typeC ? P->yc : P->yb) + tok0 * 512 + head * 64;
    if (!typeC) {
      attn_item(Q, Kp, Vt, LFULL, 72, 0, 0, 0, false, 0.f, Y, (bf16_t*)smem);
    } else {
      const int start = qb * 128;
      const int lo = start - 128 < 0 ? 0 : start - 128;
      const int hi = start + 256 > 4096 ? 4096 : start + 256;
      attn_item(Q, Kp, Vt, LFULL, 8, (512 + lo) >> 6, (512 + hi) >> 6, 512 + start, true, P->sink[l * 8 + head], Y, (bf16_t*)smem);
    }
    return;
  }
  item -= MIX_BL + MIX_CL;
  if (item < MIX_GC) { gdn_scan_item(P, l, item >> 4, (item >> 1) & 7, item & 1, smem); return; }
  item -= MIX_GC;
  {
    const int typeC = item >= MIX_BC;
    const int i = typeC ? item - MIX_BC : item;
    const int b = i >> 4, head = (i >> 1) & 7, qb = i & 1, kvh = head >> 2;
    const size_t tok0 = (size_t)b * 256 + qb * 128;
    const bf16_t* Q = (typeC ? P->qC : P->qB) + tok0 * 512 + head * 64;
    const bf16_t* Kp = (typeC ? P->kcC : P->kcB) + (size_t)(b * 2 + kvh) * 256 * 64;
    const bf16_t* Vt = (typeC ? P->vtcC : P->vtcB) + (size_t)(b * 2 + kvh) * 64 * 256;
    bf16_t* Y = (typeC ? P->yc : P->yb) + tok0 * 512 + head * 64;
    attn_item(Q, Kp, Vt, 256, 4, 0, 0, 0, typeC != 0, typeC ? P->sink[l * 8 + head] : 0.f, Y, (bf16_t*)smem);
  }
}

constexpr int GDNOUT_N = NTOK / 4;
DI void gdnout_item(CP P, int l, int item) {
  const int tid = tidx(), lane = tid & 63, wid = tid >> 6;
  const size_t base = (size_t)(item * 4 + wid) * 512 + lane;
  float o[8], zz[8];
#pragma unroll
  for (int hh = 0; hh < 8; hh++) {
    const size_t idx = base + hh * 64;
    o[hh] = bf2f(P->obf[idx]) + bf2f(P->obf[(size_t)NTOK * 512 + idx]);
    zz[hh] = bf2f(P->z[idx]);
  }
  const float an = P->a_norm[l * 64 + lane];
#pragma unroll
  for (int hh = 0; hh < 8; hh++) {
    const float ss = wave_sum(o[hh] * o[hh]);
    const float on = o[hh] * rsqrtf(ss * (1.f / 64.f) + EPS) * an;
    P->ya[base + hh * 64] = f2bf(on * siluf_(zz[hh]));
  }
}

#define XB_TMO      128
#define XB_XCNT(j)  (256  + 64 * (j))
#define XB_XSUB(j)  (1280 + 64 * (j))
#define XB_XGEN(j)  (2304 + 64 * (j))
#define XB_TOP      3328
#define XB_TOPGEN   3392
#define XCD_BAR_WORDS 3456
#define XB_SPIN_CAP (1u << 22)
#define LAS __attribute__((address_space(3)))
DI unsigned xb_ld(unsigned* p) { return __hip_atomic_load(p, __ATOMIC_RELAXED, __HIP_MEMORY_SCOPE_AGENT); }
DI unsigned xb_add(unsigned* p, unsigned v) { return __hip_atomic_fetch_add(p, v, __ATOMIC_RELAXED, __HIP_MEMORY_SCOPE_AGENT); }
DI unsigned xb_xcc_id() { return (unsigned)__builtin_amdgcn_s_getreg((3 << 11) | 20) & 0xFu; }
#define XB_SPIN(cond, bar) do { unsigned _sp = 0; while (cond) { __builtin_amdgcn_s_sleep(1); \
    if ((++_sp & 255u) == 0u) { if (xb_ld(&(bar)[XB_TMO])) break; if (_sp > XB_SPIN_CAP) { atomicAdd(&(bar)[XB_TMO], 1u); break; } } } } while (0)
struct XcdBarrier { unsigned* bar; unsigned x; volatile LAS unsigned* st; };
DI XcdBarrier xcd_barrier_post(unsigned* bar, volatile LAS unsigned* st) {
  XcdBarrier b; b.bar = bar; b.x = xb_xcc_id(); b.st = st;
  if (threadIdx.x == 0) (void)xb_add(&bar[XB_XCNT(b.x)], 1u);
  return b;
}
DI void xcd_barrier_complete(unsigned* bar, unsigned x, unsigned& nloc, unsigned& nx) {
  const unsigned G = gridDim.x * gridDim.y * gridDim.z;
  unsigned sum, cnt, mine, sp = 0u;
  for (;;) {
    sum = 0u; cnt = 0u; mine = 0u;
#pragma unroll
    for (unsigned j = 0; j < 16; ++j) { const unsigned c = xb_ld(&bar[XB_XCNT(j)]); sum += c; cnt += (c > 0u) ? 1u : 0u; mine = (j == x) ? c : mine; }
    if (sum == G) break;
    __builtin_amdgcn_s_sleep(1);
    if ((++sp & 255u) == 0u) { if (xb_ld(&bar[XB_TMO])) break; if (sp > XB_SPIN_CAP) { atomicAdd(&bar[XB_TMO], 1u); break; } }
  }
  nloc = mine > 0u ? mine : 1u; nx = cnt > 0u ? cnt : 1u;
}
DI void xcd_barrier(const XcdBarrier& b) {
  asm volatile("s_waitcnt vmcnt(0)" ::: "memory");
  __syncthreads();
  if (threadIdx.x == 0) {
    unsigned* bar = b.bar;
    __builtin_amdgcn_s_waitcnt(0);
    unsigned nloc = b.st[0], nx = b.st[1];
    if (nloc == 0u) { xcd_barrier_complete(bar, b.x, nloc, nx); b.st[0] = nloc; b.st[1] = nx; }
    const unsigned old = xb_add(&bar[XB_XSUB(b.x)], 1u);
    const unsigned gen = old / nloc;
    if (old + 1u == (gen + 1u) * nloc) {
      __builtin_amdgcn_fence(__ATOMIC_RELEASE, "agent");
      asm volatile("s_waitcnt vmcnt(0)" ::: "memory");
      const unsigned og = xb_add(&bar[XB_TOP], 1u);
      const unsigned tg = og / nx;
      if (og + 1u == (tg + 1u) * nx) xb_add(&bar[XB_TOPGEN], 1u);
      else XB_SPIN(xb_ld(&bar[XB_TOPGEN]) == tg, bar);
      __builtin_amdgcn_fence(__ATOMIC_ACQUIRE, "agent");
      xb_add(&bar[XB_XGEN(b.x)], 1u);
      asm volatile("s_waitcnt vmcnt(0)" ::: "memory");
    } else {
      XB_SPIN(xb_ld(&bar[XB_XGEN(b.x)]) == gen, bar);
      __builtin_amdgcn_fence(__ATOMIC_ACQUIRE, "agent");
      asm volatile("s_waitcnt vmcnt(0)" ::: "memory");
    }
  }
  __syncthreads();
}

enum { PH_PREP = 0, PH_NORM1, PH_GEMM_IN, PH_FEAT, PH_MIX, PH_GDNOUT, PH_GEMM_BR, PH_GEMM_O, PH_NORM2, PH_FF1, PH_FF2, PH_COUNT };

__host__ __device__ inline int phase_count(int ph) {
  switch (ph) {
    case PH_PREP: return PREP_N;
    case PH_NORM1: return NORM1_N;
    case PH_GEMM_IN: return GEMM_IN_N;
    case PH_FEAT: return GDNA_N;
    case PH_MIX: return MIX_N;
    case PH_GDNOUT: return GDNOUT_N;
    case PH_GEMM_BR: return GEMM_BR_N;
    case PH_GEMM_O: return GEMM_FF2R_N;
    case PH_NORM2: return NORM_ROWS;
    case PH_FF1: return GEMM_FF1_N;
    case PH_FF2: return GEMM_FF2R_N;
  }
  return 0;
}

DI void run_item(CP P, int ph, int l, int item, char* smem) {
  switch (ph) {
    case PH_PREP: prep_item(P, item, smem); break;
    case PH_NORM1: if (item < NORM_ROWS) modnorm_item(P, l, 0, item); else cache_item(P, l, item - NORM_ROWS); break;
    case PH_GEMM_IN: gemm_in_item(P, l, item, smem); break;
    case PH_FEAT: gdn_a_item(P, l, item, smem); break;
    case PH_MIX: mix_item(P, l, item, smem); break;
    case PH_GDNOUT: gdnout_item(P, l, item); break;
    case PH_GEMM_BR: gemm_br_item(P, l, item, smem); break;
    case PH_GEMM_O: gemm_res_ring_item(P, l, item, smem, P->h, 1024, P->wt_o + (size_t)l * 1024 * 1024, 2048); break;
    case PH_NORM2: modnorm_item(P, l, 1, item); break;
    case PH_FF1: gemm_ff1_item(P, l, item, smem); break;
    case PH_FF2: gemm_res_ring_item(P, l, item, smem, P->f, 4096, P->wt_ff2 + (size_t)l * 1024 * 4096, 5120); break;
  }
}

#if !MEGA
template <int PH>
__global__ void __launch_bounds__(256, 2) k_phase(Params Pk, int l) {
  __shared__ __attribute__((aligned(16))) char smem[SMEM_BYTES];
  CP P = launder_params();
  const int n = phase_count(PH);
  for (int item = blockIdx.x; item < n; item += gridDim.x) run_item(P, PH, l, item, smem);
}
#else
template <int PH>
DI void phase_loop(int l, char* smem) {
  CP P = launder_params();
  const int n = phase_count(PH);
#pragma unroll 1
  for (int item = blockIdx.x; item < n; item += gridDim.x) run_item(P, PH, l, item, smem);
}

#ifndef PROBE_PH
#define PROBE_PH -1
#endif
#define GSYNC() xcd_barrier(xb)
#define RUNPH(PH_) do { phase_loop<PH_>(l, smem); GSYNC(); if (PROBE_PH == PH_) { phase_loop<PH_>(l, smem); GSYNC(); } } while (0)

DI void mix_loop(int l, unsigned* ctr, char* smem, int* s_item) {
  CP P = launder_params();
#pragma unroll 1
  for (;;) {
    __syncthreads();
    if (threadIdx.x == 0) *s_item = (int)atomicAdd(ctr, 1u);
    __syncthreads();
    const int item = *s_item;
    if (item >= MIX_N) break;
    run_item(P, PH_MIX, l, item, smem);
  }
}

__global__ void __launch_bounds__(256, 2) k_mega(Params Pk) {
  __shared__ __attribute__((aligned(16))) char smem[SMEM_BYTES];
  __shared__ uint4 xb_words;
  __shared__ int s_item;
  cg::grid_group grid = cg::this_grid();
  if (threadIdx.x == 0) xb_words = make_uint4(0u, 0u, 0u, 0u);
  __syncthreads();
  const XcdBarrier xb = xcd_barrier_post(launder_params()->bar, (volatile LAS unsigned*)&xb_words);
  phase_loop<PH_PREP>(0, smem);
  if (launder_params()->never) grid.sync();
  GSYNC();
  if (PROBE_PH == PH_PREP) { phase_loop<PH_PREP>(0, smem); GSYNC(); }
#pragma unroll 1
  for (int l = 0; l < 4; l++) {
    RUNPH(PH_NORM1);
    RUNPH(PH_GEMM_IN);
    RUNPH(PH_FEAT);
    mix_loop(l, launder_params()->counters + l, smem, &s_item);
    GSYNC();
    if (PROBE_PH == PH_MIX) { mix_loop(l, launder_params()->counters + 8 + l, smem, &s_item); GSYNC(); }
    RUNPH(PH_GDNOUT);
    RUNPH(PH_GEMM_BR);
    phase_loop<PH_GEMM_O>(l, smem); GSYNC();
    RUNPH(PH_NORM2);
    RUNPH(PH_FF1);
    phase_loop<PH_FF2>(l, smem); GSYNC();
  }
}
#endif

static inline size_t align_up(size_t x) { return (x + 255) & ~(size_t)255; }

extern "C" void kernel_launch(void* const* d_in, const int* in_sizes, int n_in, void* d_out, int out_size, void* d_ws, size_t ws_size, hipStream_t stream) {
  Params P;
  memset(&P, 0, sizeof(P));
  P.x_prompt = (const float*)d_in[0]; P.x_sample = (const float*)d_in[1];
  P.ckg = (const float*)d_in[2]; P.cvg = (const float*)d_in[3]; P.ckw = (const float*)d_in[4]; P.cvw = (const float*)d_in[5];
  P.state = (const float*)d_in[6]; P.c = (const float*)d_in[7]; P.c_ctx = (const float*)d_in[8];
  P.w_mod = (const float*)d_in[9]; P.b_mod = (const float*)d_in[10]; P.ln1 = (const float*)d_in[11]; P.ln2 = (const float*)d_in[12];
  P.w_in = (const float*)d_in[13]; P.conv = (const float*)d_in[14]; P.a_log = (const float*)d_in[15]; P.dt_bias = (const float*)d_in[16];
  P.a_norm = (const float*)d_in[17]; P.qk_norm = (const float*)d_in[18]; P.sink = (const float*)d_in[19];
  P.w_br_a = (const float*)d_in[20]; P.w_br_b = (const float*)d_in[21]; P.w_br_c = (const float*)d_in[22];
  P.w_o = (const float*)d_in[23]; P.w_ff1 = (const float*)d_in[24]; P.w_ff2 = (const float*)d_in[25];
  P.out = (float*)d_out;
  char* ws = (char*)d_ws;
  size_t off = 0;
  auto take = [&](size_t bytes) { char* p = ws + off; off = align_up(off + bytes); return p; };
  P.wt_in = (bf16_t*)take((size_t)4 * NCOLP * 1024 * 2);
  P.wt_br = (bf16_t*)take((size_t)4 * 3 * 1024 * 512 * 2);
  P.wt_o = (bf16_t*)take((size_t)4 * 1024 * 1024 * 2);
  P.wt_ff1 = (bf16_t*)take((size_t)4 * 4096 * 1024 * 2);
  P.wt_ff2 = (bf16_t*)take((size_t)4 * 4096 * 1024 * 2);
  P.mods = (float*)take((size_t)4 * 3 * 6144 * 4);
  P.ropec = (float*)take((size_t)4096 * 32 * 4);
  P.ropes = (float*)take((size_t)4096 * 32 * 4);
  P.counters = (unsigned*)take(1024);
  P.bar = (unsigned*)take((size_t)XCD_BAR_WORDS * 4);
  P.h = (bf16_t*)take((size_t)NTOK * DM * 2);
  P.kfB = (bf16_t*)take((size_t)4 * LFULL * 64 * 2);
  P.vtfB = (bf16_t*)take((size_t)4 * LFULL * 64 * 2);
  P.kfC = (bf16_t*)take((size_t)4 * LFULL * 64 * 2);
  P.vtfC = (bf16_t*)take((size_t)4 * LFULL * 64 * 2);
  P.kcB = (bf16_t*)take((size_t)32 * 256 * 64 * 2);
  P.vtcB = (bf16_t*)take((size_t)32 * 256 * 64 * 2);
  P.kcC = (bf16_t*)take((size_t)32 * 256 * 64 * 2);
  P.vtcC = (bf16_t*)take((size_t)32 * 256 * 64 * 2);
  P.ba = (float*)take((size_t)NTOK * 32 * 4);
  P.bg = (float*)take((size_t)NTOK * 32 * 4);
  P.yb = (bf16_t*)take((size_t)NTOK * 512 * 2);
  P.yc = (bf16_t*)take((size_t)NTOK * 512 * 2);
  P.qC = (bf16_t*)take((size_t)NTOK * 512 * 2);
  char* fregion = take((size_t)NTOK * DFF * 2);
  P.f = (bf16_t*)fregion;
  P.gates = (bf16_t*)fregion;
  P.z = (bf16_t*)(fregion + (size_t)NTOK * 3072 * 2);
  P.qB = (bf16_t*)(fregion + (size_t)NTOK * 3072 * 2 + (size_t)NTOK * 512 * 2);
  P.gq = (bf16_t*)take((size_t)NTOK * 512 * 2);
  P.gkT = (bf16_t*)take((size_t)NTOK * 512 * 2);
  P.gw = (bf16_t*)take((size_t)2 * NTOK * 512 * 2);
  P.gu = (bf16_t*)take((size_t)2 * NTOK * 512 * 2);
  P.gattn = P.h;
  P.geg = (float*)take((size_t)2 * NTOK * 8 * 4);
  P.gks = (float*)take((size_t)2 * NTOK * 8 * 4);
  P.ggl = (float*)take((size_t)2 * 1536 * 4);
  P.ya = P.gq;
  char* oregion = take((size_t)NTOK * 1536 * 2);
  P.obf = (bf16_t*)oregion;
  P.qkv_raw = (bf16_t*)oregion;
  if (off > ws_size) { fprintf(stderr, "workspace too small: need %zu have %zu\n", off, ws_size); return; }

#if !MEGA
#define LAUNCH(PH, l) hipLaunchKernelGGL(k_phase<PH>, dim3(phase_count(PH) < 8192 ? phase_count(PH) : 8192), dim3(256), 0, stream, P, l)
  LAUNCH(PH_PREP, 0);
  for (int l = 0; l < 4; l++) {
    LAUNCH(PH_NORM1, l); LAUNCH(PH_GEMM_IN, l); LAUNCH(PH_FEAT, l); LAUNCH(PH_MIX, l); LAUNCH(PH_GDNOUT, l);
    LAUNCH(PH_GEMM_BR, l); LAUNCH(PH_GEMM_O, l); LAUNCH(PH_NORM2, l); LAUNCH(PH_FF1, l); LAUNCH(PH_FF2, l);
  }
#else
  static int grid_blocks = 0;
  if (!grid_blocks) {
    int dev = 0, cus = 0, per_cu = 0;
    hipGetDevice(&dev);
    hipDeviceGetAttribute(&cus, hipDeviceAttributeMultiprocessorCount, dev);
    hipOccupancyMaxActiveBlocksPerMultiprocessor(&per_cu, k_mega, 256, 0);
    if (per_cu > 2) per_cu = 2;
    grid_blocks = cus * per_cu;
  }
  hipMemsetAsync(P.bar, 0, (size_t)XCD_BAR_WORDS * 4, stream);
  void* args[] = {&P};
  hipError_t e = hipLaunchCooperativeKernel((void*)k_mega, dim3(grid_blocks), dim3(256), args, 0, stream);
  if (e != hipSuccess) fprintf(stderr, "cooperative launch failed: %s (grid %d)\n", hipGetErrorString(e), grid_blocks);
#endif
}
```
